# Optimizing an MI355X kernel written in HIP

```python
import jax, jax.numpy as jnp
from jax import lax
import numpy as np

D_MODEL = 1024
BATCH = 1
SEQ = 16384
DEPTH = 1
DEC_BATCH = 16
DEC_SEQ = 16
PAST_LEN = 1024

CHUNK = 64
HEAD_DIM = 64
H_FOX = 8
H_RWKV = 8
FOX_WIDTH = H_FOX * HEAD_DIM
RWKV_WIDTH = H_RWKV * HEAD_DIM
MIX_WIDTH = FOX_WIDTH + RWKV_WIDTH
DECAY_LORA = 64
AAA_LORA = 64
GATE_LORA = 128
FOX_PROJ = 3 * FOX_WIDTH + H_FOX
RWKV_PROJ = 3 * RWKV_WIDTH + DECAY_LORA + AAA_LORA + GATE_LORA
PROJ_WIDTH = FOX_PROJ + RWKV_PROJ
D_FF = 2816
Q_BLOCK = 128
RMS_EPS = 1e-6
GN_EPS = 64e-5

kernel_name = "fox_rwkv7_macaron_stream_step"


def rms_norm(x, g):
    xf = x.astype(jnp.float32)
    y = xf * lax.rsqrt(jnp.mean(xf * xf, axis=-1, keepdims=True) + RMS_EPS)
    return (y * g.astype(jnp.float32)).astype(x.dtype)


def swiglu_ffn(x, w_in, w_out):
    gate, up = jnp.split(x @ w_in, 2, axis=-1)
    return (jax.nn.silu(gate) * up) @ w_out


def fox_attend(q, c_q, q_pos, k, v, c_k, k_pos):
    s = jnp.einsum('bqhd,bkhd->bhqk', q, k).astype(jnp.float32) * (HEAD_DIM ** -0.5)
    bias = jnp.transpose(c_q, (0, 2, 1))[..., :, None] - jnp.transpose(c_k, (0, 2, 1))[..., None, :]
    mask = k_pos[None, :] <= q_pos[:, None]
    s = jnp.where(mask, s + bias, -jnp.inf)
    p = jax.nn.softmax(s, axis=-1)
    return jnp.einsum('bhqk,bkhd->bqhd', p.astype(v.dtype), v)


def fox_prompt(q, k, v, c):
    B, T = q.shape[:2]
    nb = T // Q_BLOCK
    pos = jnp.arange(T)
    qb = q.reshape(B, nb, Q_BLOCK, H_FOX, HEAD_DIM).transpose(1, 0, 2, 3, 4)
    cb = c.reshape(B, nb, Q_BLOCK, H_FOX).transpose(1, 0, 2, 3)
    pb = pos.reshape(nb, Q_BLOCK)
    out = lax.map(lambda a: fox_attend(a[0], a[1], a[2], k, v, c, pos), (qb, cb, pb))
    return out.transpose(1, 0, 2, 3, 4).reshape(B, T, H_FOX, HEAD_DIM)


def rwkv7_step(s, inp):
    r, w, k, v, kk, b = inp
    sa = jnp.einsum('bhvk,bhk->bhv', s, -kk)
    s = s * w[:, :, None, :] + sa[..., :, None] * b[..., None, :] + v[..., :, None] * k[..., None, :]
    return s, jnp.einsum('bhvk,bhk->bhv', s, r)


def rwkv7_scan(s0, r, w, k, v, kk, b):
    B, T = r.shape[:2]
    blk = CHUNK if T % CHUNK == 0 else T

    def to_blocks(t):
        return jnp.moveaxis(t, 1, 0).reshape(T // blk, blk, B, H_RWKV, HEAD_DIM)

    xs = tuple(to_blocks(t) for t in (r, w, k, v, kk, b))

    def block_step(s, xb):
        return lax.scan(rwkv7_step, s, xb)

    s_fin, ys = lax.scan(block_step, s0, xs)
    return s_fin, jnp.moveaxis(ys.reshape(T, B, H_RWKV, HEAD_DIM), 0, 1)


def trunk_layer(x, past_k, past_v, past_logf, s0, shift0,
                norm_ffn1_g, ffn1_w_in, ffn1_w_out, norm_mix_g, w_in, w_out,
                fox_b_f, fox_q_norm_g, fox_k_norm_g,
                rwkv_mu, rwkv_w0, rwkv_w2, rwkv_a0, rwkv_a2, rwkv_g2,
                rwkv_k_k, rwkv_k_a, rwkv_r_k, rwkv_ln_g, rwkv_ln_b,
                norm_ffn2_g, ffn2_w_in, ffn2_w_out):
    B, T, _ = x.shape
    f32 = jnp.float32
    x = x + 0.5 * swiglu_ffn(rms_norm(x, norm_ffn1_g), ffn1_w_in, ffn1_w_out)
    h = rms_norm(x, norm_mix_g)
    proj = h @ w_in
    p_fox, p_rw = proj[..., :FOX_PROJ], proj[..., FOX_PROJ:]

    q = rms_norm(p_fox[..., :FOX_WIDTH].reshape(B, T, H_FOX, HEAD_DIM), fox_q_norm_g)
    k = rms_norm(p_fox[..., FOX_WIDTH:2 * FOX_WIDTH].reshape(B, T, H_FOX, HEAD_DIM), fox_k_norm_g)
    v = p_fox[..., 2 * FOX_WIDTH:3 * FOX_WIDTH].reshape(B, T, H_FOX, HEAD_DIM)
    logf = jax.nn.log_sigmoid((p_fox[..., 3 * FOX_WIDTH:] + fox_b_f).astype(f32))
    if past_k is None:
        o_fox = fox_prompt(q, k, v, jnp.cumsum(logf, axis=1))
    else:
        P = past_k.shape[1]
        k_all = jnp.concatenate([past_k.astype(k.dtype), k], axis=1)
        v_all = jnp.concatenate([past_v.astype(v.dtype), v], axis=1)
        c_all = jnp.cumsum(jnp.concatenate([past_logf.astype(f32), logf], axis=1), axis=1)
        pos = jnp.arange(P + T)
        o_fox = fox_attend(q, c_all[:, P:], pos[P:], k_all, v_all, c_all, pos)

    prev = jnp.concatenate([shift0.astype(p_rw.dtype), p_rw[:, :-1]], axis=1)
    xs = p_rw + (prev - p_rw) * rwkv_mu
    W = RWKV_WIDTH
    r, kr, vr, wd, ad, gd = jnp.split(
        xs, [W, 2 * W, 3 * W, 3 * W + DECAY_LORA, 3 * W + DECAY_LORA + AAA_LORA], axis=-1)
    w_log = -jax.nn.softplus(-(rwkv_w0 + jnp.tanh(wd) @ rwkv_w2)) - 0.5
    decay = jnp.exp(-jnp.exp(w_log.astype(f32)))
    a = jax.nn.sigmoid(rwkv_a0 + ad @ rwkv_a2)
    g = jax.nn.sigmoid(gd) @ rwkv_g2

    def heads(t):
        return t.reshape(B, T, H_RWKV, HEAD_DIM).astype(f32)

    kk = heads(kr * rwkv_k_k)
    kk = kk / jnp.maximum(jnp.sqrt(jnp.sum(kk * kk, axis=-1, keepdims=True)), 1e-12)
    kr = kr * (1 + (a - 1) * rwkv_k_a)
    r_h, k_h, v_h, a_h, w_h = heads(r), heads(kr), heads(vr), heads(a), heads(decay)
    s_new, y = rwkv7_scan(s0.astype(f32), r_h, w_h, k_h, v_h, kk, kk * a_h)
    mean = jnp.mean(y, axis=-1, keepdims=True)
    var = jnp.mean(jnp.square(y - mean), axis=-1, keepdims=True)
    y = ((y - mean) * lax.rsqrt(var + GN_EPS)).reshape(B, T, W) * rwkv_ln_g + rwkv_ln_b
    y = y + (jnp.sum(r_h * k_h * rwkv_r_k, axis=-1, keepdims=True) * v_h).reshape(B, T, W)
    o_rwkv = (y * g).astype(x.dtype)

    mix = jnp.concatenate([o_fox.reshape(B, T, FOX_WIDTH), o_rwkv], axis=-1) @ w_out
    x = x + mix
    x = x + 0.5 * swiglu_ffn(rms_norm(x, norm_ffn2_g), ffn2_w_in, ffn2_w_out)
    return x, (k, v, logf, s_new, p_rw[:, -1:])


def setup_inputs(seed: int = 0) -> dict:
    key = jax.random.key(seed)
    ks = iter(jax.random.split(key, 40))
    L = DEPTH

    def nrm(shape, scale):
        return jax.random.normal(next(ks), shape, jnp.float32) * scale

    def unif(shape, lo, hi):
        return jax.random.uniform(next(ks), shape, jnp.float32, lo, hi)

    return {
        "x_prompt": nrm((BATCH, SEQ, D_MODEL), 1.0),
        "x_sample": nrm((DEC_BATCH, DEC_SEQ, D_MODEL), 1.0),
        "cache_fox_k": nrm((L, DEC_BATCH, PAST_LEN, H_FOX, HEAD_DIM), 1.0),
        "cache_fox_v": nrm((L, DEC_BATCH, PAST_LEN, H_FOX, HEAD_DIM), 1.0),
        "cache_fox_logf": jax.nn.log_sigmoid(3.0 + nrm((L, DEC_BATCH, PAST_LEN, H_FOX), 0.5)),
        "state_rwkv": nrm((L, DEC_BATCH, H_RWKV, HEAD_DIM, HEAD_DIM), 0.1),
        "state_rwkv_shift": nrm((L, DEC_BATCH, 1, RWKV_PROJ), 1.0),
        "norm_ffn1_g": 1.0 + nrm((L, D_MODEL), 0.05),
        "ffn1_w_in": nrm((L, D_MODEL, 2 * D_FF), D_MODEL ** -0.5),
        "ffn1_w_out": nrm((L, D_FF, D_MODEL), D_FF ** -0.5),
        "norm_mix_g": 1.0 + nrm((L, D_MODEL), 0.05),
        "w_in": nrm((L, D_MODEL, PROJ_WIDTH), D_MODEL ** -0.5),
        "w_out": nrm((L, MIX_WIDTH, D_MODEL), MIX_WIDTH ** -0.5),
        "fox_b_f": 3.0 + nrm((L, H_FOX), 0.5),
        "fox_q_norm_g": 1.0 + nrm((L, HEAD_DIM), 0.05),
        "fox_k_norm_g": 1.0 + nrm((L, HEAD_DIM), 0.05),
        "rwkv_mu": unif((L, RWKV_PROJ), 0.2, 0.8),
        "rwkv_w0": unif((L, RWKV_WIDTH), -6.0, 1.0),
        "rwkv_w2": nrm((L, DECAY_LORA, RWKV_WIDTH), 0.5 * DECAY_LORA ** -0.5),
        "rwkv_a0": nrm((L, RWKV_WIDTH), 0.3),
        "rwkv_a2": nrm((L, AAA_LORA, RWKV_WIDTH), 0.5 * AAA_LORA ** -0.5),
        "rwkv_g2": nrm((L, GATE_LORA, RWKV_WIDTH), GATE_LORA ** -0.5),
        "rwkv_k_k": 0.85 + nrm((L, RWKV_WIDTH), 0.05),
        "rwkv_k_a": 1.0 + nrm((L, RWKV_WIDTH), 0.1),
        "rwkv_r_k": nrm((L, H_RWKV, HEAD_DIM), 0.1),
        "rwkv_ln_g": 1.0 + nrm((L, RWKV_WIDTH), 0.05),
        "rwkv_ln_b": nrm((L, RWKV_WIDTH), 0.02),
        "norm_ffn2_g": 1.0 + nrm((L, D_MODEL), 0.05),
        "ffn2_w_in": nrm((L, D_MODEL, 2 * D_FF), D_MODEL ** -0.5),
        "ffn2_w_out": nrm((L, D_FF, D_MODEL), D_FF ** -0.5),
    }


def reference(x_prompt, x_sample, cache_fox_k, cache_fox_v, cache_fox_logf, state_rwkv, state_rwkv_shift,
              norm_ffn1_g, ffn1_w_in, ffn1_w_out, norm_mix_g, w_in, w_out,
              fox_b_f, fox_q_norm_g, fox_k_norm_g,
              rwkv_mu, rwkv_w0, rwkv_w2, rwkv_a0, rwkv_a2, rwkv_g2,
              rwkv_k_k, rwkv_k_a, rwkv_r_k, rwkv_ln_g, rwkv_ln_b,
              norm_ffn2_g, ffn2_w_in, ffn2_w_out):
    weights = (norm_ffn1_g, ffn1_w_in, ffn1_w_out, norm_mix_g, w_in, w_out,
               fox_b_f, fox_q_norm_g, fox_k_norm_g,
               rwkv_mu, rwkv_w0, rwkv_w2, rwkv_a0, rwkv_a2, rwkv_g2,
               rwkv_k_k, rwkv_k_a, rwkv_r_k, rwkv_ln_g, rwkv_ln_b,
               norm_ffn2_g, ffn2_w_in, ffn2_w_out)
    bp = x_prompt.shape[0]
    yp, ys = x_prompt, x_sample
    prompt_states = ([], [], [], [], [])
    sample_states = ([], [], [], [], [])
    for l in range(DEPTH):
        lw = [w[l] for w in weights]
        s0 = jnp.zeros((bp, H_RWKV, HEAD_DIM, HEAD_DIM), jnp.float32)
        sh0 = jnp.zeros((bp, 1, RWKV_PROJ), x_prompt.dtype)
        yp, st_p = trunk_layer(yp, None, None, None, s0, sh0, *lw)
        ys, st_s = trunk_layer(ys, cache_fox_k[l], cache_fox_v[l], cache_fox_logf[l],
                               state_rwkv[l], state_rwkv_shift[l], *lw)
        for acc, st in zip(prompt_states, st_p):
            acc.append(st)
        for acc, st in zip(sample_states, st_s):
            acc.append(st)
    new_fox_k_prompt = jnp.stack(prompt_states[0])
    new_fox_v_prompt = jnp.stack(prompt_states[1])
    new_fox_logf_prompt = jnp.stack(prompt_states[2])
    new_rwkv_state_prompt = jnp.stack(prompt_states[3])
    new_rwkv_shift_prompt = jnp.stack(prompt_states[4])
    new_fox_k_sample = jnp.stack(sample_states[0])
    new_fox_v_sample = jnp.stack(sample_states[1])
    new_fox_logf_sample = jnp.stack(sample_states[2])
    new_rwkv_state_sample = jnp.stack(sample_states[3])
    new_rwkv_shift_sample = jnp.stack(sample_states[4])
    return (yp, ys,
            new_fox_k_prompt, new_fox_v_prompt, new_fox_logf_prompt, new_rwkv_state_prompt, new_rwkv_shift_prompt,
            new_fox_k_sample, new_fox_v_sample, new_fox_logf_sample, new_rwkv_state_sample, new_rwkv_shift_sample)
```

```cpp
#include <hip/hip_runtime.h>
#include <hip/hip_cooperative_groups.h>
#include <cstdio>
#include <cstdint>
namespace cg = cooperative_groups;
namespace pg8 {
#define PG8_LAS __attribute__((address_space(3)))
typedef unsigned short bf16_t;
typedef short bf16x8 __attribute__((ext_vector_type(8)));
typedef float f32x4 __attribute__((ext_vector_type(4)));
typedef unsigned u32x4 __attribute__((ext_vector_type(4)));
constexpr int BM = 256, BK = 64, HALF = 128, HTB = HALF * BK * 2  , STAGE_BYTES = 8 * HTB, NXCD = 8, WGM = 8;

__host__ __device__ __forceinline__ int lds_byte(int r, int c) { const int st = (r >> 4) * 2 + (c >> 5), rr = r & 15, cc = c & 31, ob = rr * 64 + cc * 2; return st * 1024 + (ob ^ (((ob >> 9) & 1) << 5)); }
__host__ __device__ __forceinline__ void stage_rc(int b, int& R, int& C) { const int st = b / 1024, sb = b % 1024, swz = sb ^ (((sb >> 9) & 1) << 5); R = (st >> 1) * 16 + swz / 64; C = (st & 1) * 32 + (swz % 64) / 2; }
__host__ __device__ __forceinline__ int perm32(int rho) { const int n = rho >> 4, i = rho & 15; return 8 * (i >> 2) + 4 * n + (i & 3); }

struct Unit { int pm, pn; };
struct Gemm { const bf16_t* A; const bf16_t* Bt; int M, N, K; };

struct StaticOrder {
    int nM, nN, nwg, G, c;
    __host__ __device__ void init(int M, int N, int G_, int c_) { nM = M / BM; nN = N / BM; nwg = nM * nN; G = G_; c = c_; }
    __host__ __device__ bool next(int i, Unit& u) const {
        const long L = (long)i * G + c; if (L >= nwg) return false;
        int wgid = (int)L; { const int q = nwg / NXCD, r = nwg % NXCD, xcd = wgid % NXCD, off = wgid / NXCD; wgid = (xcd < r ? xcd * (q + 1) : r * (q + 1) + (xcd - r) * q) + off; }
        const int nig = WGM * nN, gid = wgid / nig, fm = gid * WGM, gsz = (nM - fm) < WGM ? (nM - fm) : WGM;
        u.pm = fm + ((wgid % nig) % gsz); u.pn = (wgid % nig) / gsz; return true;
    }
    __device__ __forceinline__ void a_ready(const Unit&) const {}
    __device__ __forceinline__ void done(const Unit&) const {}
};

__device__ __forceinline__ unsigned cvt_pk_bf16(float lo, float hi) { unsigned r; asm volatile("v_cvt_pk_bf16_f32 %0, %1, %2" : "=v"(r) : "v"(lo), "v"(hi)); return r; }
template <class Epi, class Sched, bool ALIGN_EPI = false, bool SP2 = false>
__device__ __forceinline__ void gemm_phase(PG8_LAS unsigned char* lds, const Gemm g, const Sched& S, const Epi& E) {
    int tid_l = threadIdx.x; asm volatile("" : "+v"(tid_l));
    const int tid = tid_l, wid = __builtin_amdgcn_readfirstlane(tid >> 6), lane = tid & 63, wr = wid >> 2, wc = wid & 3, fr = lane & 15, fq = lane >> 4;
    const int K = g.K, nt = K / BK;
    unsigned voffA[2], voffB[2];
#pragma unroll
    for (int i = 0; i < 2; ++i) { int R, C; stage_rc(tid * 16 + i * 8192, R, C); const int Rb = Epi::PERM ? ((R & ~31) + perm32(R & 31)) : R;
        voffA[i] = (unsigned)(R * K + C) * 2u; voffB[i] = (unsigned)(Rb * K + C) * 2u; }
    const size_t kstep = (size_t)(BK * 2);
    const size_t hstep = (size_t)HALF * K * 2;
    const size_t tstep = 2 * hstep;
    const unsigned ldsw = (unsigned)wid * 1024u;
    const int aoff = lds_byte(wr * 64 + fr, fq * 8), boff = lds_byte(wc * 32 + fr, fq * 8);
#define PG8_SA(b, h) (((b) * 2 + (h)) * HTB)
#define PG8_SB(b, h) ((4 + (b) * 2 + (h)) * HTB)
#define PG8_STAGE(bufoff, gbase, voff) do { _Pragma("unroll") for (int _i = 0; _i < 2; ++_i) \
        __builtin_amdgcn_global_load_lds((const unsigned*)((const char*)(gbase) + (voff)[_i]), (PG8_LAS unsigned*)(lds + (bufoff) + ldsw + _i * 8192), 16, 0, 0); } while (0)
#define PG8_LDA(dst, b, h) do { _Pragma("unroll") for (int m = 0; m < 4; ++m) _Pragma("unroll") for (int k = 0; k < 2; ++k) dst[m][k] = *(const PG8_LAS bf16x8*)(lds + PG8_SA(b, h) + aoff + m * 2048 + k * 1024); } while (0)
#define PG8_LDB(dst, b, h) do { _Pragma("unroll") for (int n = 0; n < 2; ++n) _Pragma("unroll") for (int k = 0; k < 2; ++k) dst[n][k] = *(const PG8_LAS bf16x8*)(lds + PG8_SB(b, h) + boff + n * 2048 + k * 1024); } while (0)
#define PG8_MMA(ai, bj, At, Bt) do { __builtin_amdgcn_s_setprio(1); _Pragma("unroll") for (int m = 0; m < 4; ++m) _Pragma("unroll") for (int n = 0; n < 2; ++n) _Pragma("unroll") for (int k = 0; k < 2; ++k) \
        acc[ai][bj][m][n] = __builtin_amdgcn_mfma_f32_16x16x32_bf16(Bt[n][k], At[m][k], acc[ai][bj][m][n], 0, 0, 0); __builtin_amdgcn_s_setprio(0); } while (0)
#define PG8_WAIT_V(n) asm volatile("s_waitcnt vmcnt(" #n ")" ::: "memory")
#define PG8_WAIT_L(n) asm volatile("s_waitcnt lgkmcnt(" #n ")" ::: "memory")
#define PG8_BAR __builtin_amdgcn_s_barrier()
#define PG8_SCHED __builtin_amdgcn_sched_barrier(0)
    Unit cur, nxt; int ui = 0;
    if (!S.next(0, cur)) return;
    f32x4 acc[2][2][4][2];
#pragma unroll
    for (int a = 0; a < 2; ++a)
#pragma unroll
        for (int b = 0; b < 2; ++b)
#pragma unroll
            for (int m = 0; m < 4; ++m)
#pragma unroll
                for (int n = 0; n < 2; ++n) acc[a][b][m][n] = (f32x4){0.f, 0.f, 0.f, 0.f};
    bf16x8 At[4][2], B0[2][2], B1[2][2];
    const char* cA = (const char*)g.A + (size_t)cur.pm * tstep; const char* cB = (const char*)g.Bt + (size_t)cur.pn * tstep;
    S.a_ready(cur);
    if constexpr (SP2) {
        PG8_STAGE(PG8_SB(0, 0), cB, voffB); PG8_STAGE(PG8_SB(0, 1), cB + hstep, voffB); PG8_STAGE(PG8_SA(0, 0), cA, voffA); PG8_STAGE(PG8_SA(0, 1), cA + hstep, voffA);
        if (wr == 1) PG8_BAR;
        PG8_WAIT_V(2); PG8_BAR;
        PG8_STAGE(PG8_SB(1, 0), cB + kstep, voffB); PG8_STAGE(PG8_SA(1, 0), cA + kstep, voffA); PG8_STAGE(PG8_SB(1, 1), cB + hstep + kstep, voffB);
        PG8_WAIT_V(6); PG8_BAR;
    } else {
        PG8_STAGE(PG8_SB(0, 0), cB, voffB); PG8_STAGE(PG8_SA(0, 0), cA, voffA); PG8_STAGE(PG8_SB(0, 1), cB + hstep, voffB); PG8_STAGE(PG8_SA(0, 1), cA + hstep, voffA);
        if (wr == 1) PG8_BAR;
        PG8_WAIT_V(4); PG8_BAR;
        PG8_STAGE(PG8_SB(1, 0), cB + kstep, voffB); PG8_STAGE(PG8_SA(1, 0), cA + kstep, voffA); PG8_STAGE(PG8_SB(1, 1), cB + hstep + kstep, voffB);
        PG8_WAIT_V(6); PG8_BAR;
    }
    for (;;) {
        const bool has_next = S.next(ui + 1, nxt);
        const char* nA = has_next ? (const char*)g.A + (size_t)nxt.pm * tstep : cA; const char* nB = has_next ? (const char*)g.Bt + (size_t)nxt.pn * tstep : cB;
        for (int t = 0; t < nt; t += 2) {
            const bool last = (t == nt - 2);
            const char* a1 = cA + (size_t)(t + 1) * kstep;
            const char* a2 = last ? nA : cA + (size_t)(t + 2) * kstep; const char* b2 = last ? nB : cB + (size_t)(t + 2) * kstep;
            const char* a3 = a2 + kstep; const char* b3 = b2 + kstep;
            if (last && has_next) S.a_ready(nxt);
            if constexpr (SP2) {
            PG8_LDB(B0, 0, 0); PG8_LDB(B1, 0, 1); PG8_SCHED; PG8_LDA(At, 0, 0); PG8_STAGE(PG8_SA(1, 1), a1 + hstep, voffA);
            PG8_WAIT_V(8); PG8_WAIT_L(0); PG8_BAR; PG8_MMA(0, 0, At, B0); PG8_MMA(0, 1, At, B1); PG8_BAR; PG8_SCHED;
            PG8_LDA(At, 0, 1); PG8_STAGE(PG8_SB(0, 0), b2, voffB); PG8_STAGE(PG8_SB(0, 1), b2 + hstep, voffB); PG8_STAGE(PG8_SA(0, 0), a2, voffA);
            PG8_WAIT_V(8); PG8_WAIT_L(0); PG8_BAR; PG8_MMA(1, 0, At, B0); PG8_MMA(1, 1, At, B1); PG8_BAR; PG8_SCHED;
            PG8_LDB(B0, 1, 0); PG8_LDB(B1, 1, 1); PG8_SCHED; PG8_LDA(At, 1, 0); PG8_STAGE(PG8_SA(0, 1), a2 + hstep, voffA);
            PG8_WAIT_V(8); PG8_WAIT_L(0); PG8_BAR; PG8_MMA(0, 0, At, B0); PG8_MMA(0, 1, At, B1); PG8_BAR; PG8_SCHED;
            PG8_LDA(At, 1, 1); PG8_STAGE(PG8_SB(1, 0), b3, voffB); PG8_STAGE(PG8_SB(1, 1), b3 + hstep, voffB); PG8_STAGE(PG8_SA(1, 0), a3, voffA);
            PG8_WAIT_V(8); PG8_WAIT_L(0); PG8_BAR; PG8_MMA(1, 0, At, B0); PG8_MMA(1, 1, At, B1); PG8_BAR; PG8_SCHED;
            } else {
            PG8_LDB(B0, 0, 0); PG8_SCHED; PG8_LDA(At, 0, 0); PG8_STAGE(PG8_SA(1, 1), a1 + hstep, voffA);
            PG8_WAIT_L(8); PG8_BAR; PG8_WAIT_L(0); PG8_MMA(0, 0, At, B0); PG8_BAR; PG8_SCHED;
            PG8_LDB(B1, 0, 1); PG8_STAGE(PG8_SB(0, 0), b2, voffB);
            PG8_BAR; PG8_WAIT_L(0); PG8_MMA(0, 1, At, B1); PG8_BAR;
            PG8_LDA(At, 0, 1); PG8_STAGE(PG8_SA(0, 0), a2, voffA);
            PG8_BAR; PG8_WAIT_L(0); PG8_MMA(1, 0, At, B0); PG8_BAR; PG8_SCHED;
            PG8_STAGE(PG8_SB(0, 1), b2 + hstep, voffB);
            PG8_WAIT_V(6); PG8_BAR; PG8_MMA(1, 1, At, B1); PG8_BAR;
            PG8_LDB(B0, 1, 0); PG8_SCHED; PG8_LDA(At, 1, 0); PG8_STAGE(PG8_SA(0, 1), a2 + hstep, voffA);
            PG8_WAIT_L(8); PG8_BAR; PG8_WAIT_L(0); PG8_MMA(0, 0, At, B0); PG8_BAR; PG8_SCHED;
            PG8_LDB(B1, 1, 1); PG8_STAGE(PG8_SB(1, 0), b3, voffB);
            PG8_BAR; PG8_WAIT_L(0); PG8_MMA(0, 1, At, B1); PG8_BAR;
            PG8_LDA(At, 1, 1); PG8_STAGE(PG8_SA(1, 0), a3, voffA);
            PG8_BAR; PG8_WAIT_L(0); PG8_MMA(1, 0, At, B0); PG8_BAR; PG8_SCHED;
            PG8_STAGE(PG8_SB(1, 1), b3 + hstep, voffB);
            PG8_WAIT_V(6); PG8_BAR; PG8_MMA(1, 1, At, B1); PG8_BAR;
            }
        }
        if constexpr (ALIGN_EPI) { if (wr == 0) PG8_BAR; }
        if constexpr (!Epi::AFTER_DRAIN) { E(acc, cur, wr, wc, fr, fq); S.done(cur); }
        if (!has_next) break;
#pragma unroll
        for (int a = 0; a < 2; ++a)
#pragma unroll
            for (int b = 0; b < 2; ++b)
#pragma unroll
                for (int m = 0; m < 4; ++m)
#pragma unroll
                    for (int n = 0; n < 2; ++n) acc[a][b][m][n] = (f32x4){0.f, 0.f, 0.f, 0.f};
        cur = nxt; cA = nA; cB = nB; ++ui;
        if constexpr (ALIGN_EPI) { if (wr == 1) PG8_BAR; }
    }
    PG8_WAIT_V(0);
    if constexpr (!ALIGN_EPI) { if (wr == 0) PG8_BAR; }
    PG8_BAR;
    if constexpr (Epi::AFTER_DRAIN) { E.fused(acc, cur, wr, wc, fr, fq, lds, wid, lane); S.done(cur); }
#undef PG8_SA
#undef PG8_SB
#undef PG8_STAGE
#undef PG8_LDA
#undef PG8_LDB
#undef PG8_MMA
#undef PG8_WAIT_V
#undef PG8_WAIT_L
#undef PG8_BAR
#undef PG8_SCHED
}
}
#define LAS __attribute__((address_space(3)))
typedef unsigned short bf16_t;
typedef float f32x4 __attribute__((ext_vector_type(4)));
typedef float f32x16 __attribute__((ext_vector_type(16)));
typedef unsigned u32x4 __attribute__((ext_vector_type(4)));
typedef unsigned u32x2 __attribute__((ext_vector_type(2)));
typedef short bf16x8 __attribute__((ext_vector_type(8)));

constexpr int TP = 16384, NSB = 16, TSS = 16, PAST = 1024, MROWS = 16640, DM = 1024, DFF = 2816, NPROJ = 3584, RWP = 1792, NLORA = 1536, KLORA = 256;
constexpr float LOG2E = 1.4426950408889634f;
constexpr float QSCALE = 0.125f * LOG2E;
constexpr size_t OFF_KP = 17039360, OFF_VP = 25427968, OFF_LFP = 33816576, OFF_STP = 33947648, OFF_SHP = 33980416, OFF_KS = 33982208, OFF_VS = 34113280,
                 OFF_LFS = 34244352, OFF_STS = 34246400, OFF_SHS = 34770688, OUT_TOTAL = 34799360;
constexpr size_t MiB = 1u << 20;
constexpr size_t WS_ROWSQ0 = 0, WS_ROWSQ1 = 128 * 1024, WS_ROWSQ2 = 256 * 1024, WS_TT = 384 * 1024;
constexpr size_t WS_LOGF = 1 * MiB, WS_CUM = 2 * MiB;
constexpr size_t WS_W1I = 3 * MiB, WS_W1O = 14 * MiB, WS_WIN = 20 * MiB, WS_WOUT = 27 * MiB, WS_W2I = 29 * MiB, WS_W2O = 40 * MiB, WS_WLORA = 46 * MiB;
constexpr size_t WS_XB = 47 * MiB;
constexpr size_t WS_Q = 80 * MiB, WS_K = 97 * MiB, WS_V = 114 * MiB;
constexpr size_t WS_X2B = 80 * MiB;
constexpr size_t WS_H = 131 * MiB;
constexpr size_t WS_PRW = 131 * MiB, WS_LORAA = 188 * MiB, WS_LORA = 197 * MiB;
constexpr size_t WS_SEG = 246 * MiB, WS_END = 256 * MiB;

struct Args { const float* in[30]; float* out; unsigned char* ws; };
typedef const __attribute__((address_space(4))) Args* CArgsP;
__device__ __forceinline__ CArgsP get_args() { CArgsP p = (CArgsP)__builtin_amdgcn_kernarg_segment_ptr(); asm volatile("" : "+s"(p)); return p; }

#define LDS_WAIT() asm volatile("s_waitcnt lgkmcnt(0)" ::: "memory")
__device__ __forceinline__ unsigned f2bf(float f) { unsigned u = __builtin_bit_cast(unsigned, f); return (u + 0x7fffu + ((u >> 16) & 1u)) >> 16; }
__device__ __forceinline__ unsigned pk2(float lo, float hi) { return f2bf(lo) | (f2bf(hi) << 16); }
__device__ __forceinline__ float bf2f(unsigned b) { return __builtin_bit_cast(float, b << 16); }
__device__ __forceinline__ float wave_sum(float v) {
#pragma unroll
    for (int o = 1; o < 64; o <<= 1) v += __shfl_xor(v, o);
    return v;
}
__device__ __forceinline__ float wave_max(float v) {
#pragma unroll
    for (int o = 1; o < 64; o <<= 1) v = fmaxf(v, __shfl_xor(v, o));
    return v;
}
template <int CTRL> __device__ __forceinline__ float dpp_f(float x) { return __builtin_bit_cast(float, __builtin_amdgcn_mov_dpp(__builtin_bit_cast(int, x), CTRL, 0xf, 0xf, true)); }
__device__ __forceinline__ float allred8(float x) { x += dpp_f<0xB1>(x); x += dpp_f<0x4E>(x); x += dpp_f<0x141>(x); return x; }

__device__ __forceinline__ void p0_item(const float* __restrict__ W, int K, int ldn, int nsrc0, int nvalid, const float* __restrict__ gain, bf16_t* WT, int dstrow0, int k0, LAS float* scr, int lane) {
    const int col = lane & 31;
#pragma unroll
    for (int i = 0; i < 32; ++i) {
        const int kk = 2 * i + (lane >> 5);
        float v = 0.f;
        if (col < nvalid) { v = W[(size_t)(k0 + kk) * ldn + nsrc0 + col]; if (gain) v *= gain[k0 + kk]; }
        scr[kk * 33 + col] = v;
    }
    LDS_WAIT();
    const int c = lane & 7;
#pragma unroll
    for (int j = 0; j < 4; ++j) {
        const int n = (lane >> 3) + 8 * j; const LAS float* s = scr + (8 * c) * 33 + n;
        u32x4 o; o.x = pk2(s[0 * 33], s[1 * 33]); o.y = pk2(s[2 * 33], s[3 * 33]); o.z = pk2(s[4 * 33], s[5 * 33]); o.w = pk2(s[6 * 33], s[7 * 33]);
        *(u32x4*)(WT + (size_t)(dstrow0 + n) * K + k0 + 8 * c) = o;
    }
    LDS_WAIT();
}

__device__ __forceinline__ void convert_tile(const float* __restrict__ W, int K, int ldn, const float* __restrict__ gain, bf16_t* WT, int pn, int k0, int kind, LAS unsigned char* lds, int wave, int lane) {
    LAS float* T = (LAS float*)lds;
    const int c = 4 * lane, q = c >> 5, db = 8 * pn + q;
    int nsrc0, nvalid = 32;
    if (kind == 0) nsrc0 = (q >> 2) * DFF + 128 * pn + 32 * (q & 3);
    else if (kind == 1) nsrc0 = 32 * db;
    else { const int l = 256 * pn + 64 * (q & 3) + 32 * (q >> 2); if (l < 1536) nsrc0 = l; else if (l < 3328) nsrc0 = l + 8; else { nsrc0 = 1536; nvalid = (l == 3328) ? 8 : 0; } }
    const bool ok = (c & 31) < nvalid;
    __syncthreads();
    f32x4 v[8];
#pragma unroll
    for (int i = 0; i < 8; ++i) { const int kk = 8 * wave + i; v[i] = (f32x4){0.f, 0.f, 0.f, 0.f}; if (ok) v[i] = *(const f32x4*)(W + (size_t)(k0 + kk) * ldn + nsrc0 + (c & 31)); }
#pragma unroll
    for (int i = 0; i < 8; ++i) { const int kk = 8 * wave + i; f32x4 t = v[i]; if (gain) t = t * gain[k0 + kk]; *(LAS f32x4*)(T + kk * 260 + c) = t; }
    __syncthreads();
    const int tid = wave * 64 + lane, n = tid & 255, hf = tid >> 8;
    u32x4 o[4];
#pragma unroll
    for (int j = 0; j < 4; ++j) {
        const LAS float* sp = T + (32 * hf + 8 * j) * 260 + n;
        o[j].x = pk2(sp[0 * 260], sp[1 * 260]); o[j].y = pk2(sp[2 * 260], sp[3 * 260]); o[j].z = pk2(sp[4 * 260], sp[5 * 260]); o[j].w = pk2(sp[6 * 260], sp[7 * 260]);
    }
    u32x4* dst = (u32x4*)(WT + (size_t)(256 * pn + n) * K + k0 + 32 * hf);
#pragma unroll
    for (int j = 0; j < 4; ++j) dst[j] = o[j];
}
__device__ __forceinline__ void convert_weights(CArgsP a, LAS unsigned char* lds, int wave, int lane, int which, int gb, int NGB) {
    unsigned char* ws = a->ws;
    constexpr int I0 = 22 * 16, I1 = 4 * 44, I2 = 14 * 16, I3 = 4 * 16;
    const int NIT = which == 0 ? I0 + I1 + I2 : I0 + I1 + I3;
    for (int it = gb; it < NIT; it += NGB) {
        int r = it;
        if (r < I0) { const int pn = r >> 4, kb = r & 15;
            convert_tile(which == 0 ? a->in[8] : a->in[28], 1024, 5632, which == 0 ? a->in[7] : a->in[27], (bf16_t*)(ws + (which == 0 ? WS_W1I : WS_W2I)), pn, 64 * kb, 0, lds, wave, lane); continue; }
        r -= I0;
        if (r < I1) { const int pn = r / 44, kb = r % 44; convert_tile(which == 0 ? a->in[9] : a->in[29], DFF, 1024, nullptr, (bf16_t*)(ws + (which == 0 ? WS_W1O : WS_W2O)), pn, 64 * kb, 1, lds, wave, lane); continue; }
        r -= I1;
        if (which == 0) { const int pn = r >> 4, kb = r & 15; convert_tile(a->in[11], 1024, 3336, a->in[10], (bf16_t*)(ws + WS_WIN), pn, 64 * kb, 2, lds, wave, lane); }
        else { const int pn = r >> 4, kb = r & 15; convert_tile(a->in[12], 1024, 1024, nullptr, (bf16_t*)(ws + WS_WOUT), pn, 64 * kb, 1, lds, wave, lane); }
    }
    __syncthreads();
}
__device__ __forceinline__ void phase0(CArgsP a, LAS unsigned char* lds, int wave, int lane) {
    const int gw = blockIdx.x * 8 + wave, NGW = gridDim.x * 8;
    unsigned char* ws = a->ws;
    convert_weights(a, lds, wave, lane, 0, blockIdx.x, gridDim.x);
    {
        bf16_t* WL = (bf16_t*)(ws + WS_WLORA);
        const int gt = blockIdx.x * 512 + threadIdx.x, NG = gridDim.x * 512;
        for (int idx = gt; idx < NLORA * KLORA; idx += NG) {
            const int n = idx >> 8, k = idx & 255; float v = 0.f;
            if (n < 512) { if (k < 64) v = a->in[18][k * 512 + n]; }
            else if (n < 1024) { if (k >= 64 && k < 128) v = a->in[20][(k - 64) * 512 + (n - 512)]; }
            else { if (k >= 128) v = a->in[21][(k - 128) * 512 + (n - 1024)]; }
            WL[idx] = (bf16_t)f2bf(v);
        }
    }
    {
        bf16_t* XB = (bf16_t*)(ws + WS_XB); float* rq0 = (float*)(ws + WS_ROWSQ0); float* rq1 = (float*)(ws + WS_ROWSQ1); float* rq2 = (float*)(ws + WS_ROWSQ2);
#pragma unroll 2
        for (int m = gw; m < MROWS; m += NGW) {
            const float* xrow = m < TP ? a->in[0] + (size_t)m * DM : a->in[1] + (size_t)(m - TP) * DM;
            const f32x4* xr = (const f32x4*)xrow + lane; f32x4 v[4]; float s = 0.f;
#pragma unroll
            for (int j = 0; j < 4; ++j) { v[j] = xr[64 * j]; s += (v[j].x * v[j].x + v[j].y * v[j].y) + (v[j].z * v[j].z + v[j].w * v[j].w); }
            s = wave_sum(s);
            u32x2* o8 = (u32x2*)(XB + (size_t)m * DM) + lane;
#pragma unroll
            for (int j = 0; j < 4; ++j) { u32x2 w; w.x = pk2(v[j].x, v[j].y); w.y = pk2(v[j].z, v[j].w); o8[64 * j] = w; }
            if (lane == 0) { rq0[m] = s; rq1[m] = 0.f; rq2[m] = 0.f; }
        }
    }
}

using pg8::cvt_pk_bf16;
struct EpiSwiglu {
    static constexpr bool PERM = true, AFTER_DRAIN = false;
    bf16_t* H; const float* rowsq;
    __device__ __forceinline__ void operator()(const pg8::f32x4 (&acc)[2][2][4][2], const pg8::Unit& u, int wr, int wc, int fr, int fq) const {
        const int row0 = u.pm * 256 + wr * 64 + fr, col0 = u.pn * 128 + wc * 32 + 8 * fq;
#pragma unroll
        for (int ai = 0; ai < 2; ++ai)
#pragma unroll
            for (int m = 0; m < 4; ++m) {
                const int row = row0 + ai * 128 + m * 16;
                const float rs = rsqrtf(rowsq[row] * (1.f / 1024.f) + 1e-6f);
                float h[8];
#pragma unroll
                for (int n = 0; n < 2; ++n)
#pragma unroll
                    for (int j = 0; j < 4; ++j) { const float g = acc[ai][0][m][n][j] * rs, up = acc[ai][1][m][n][j] * rs; h[4 * n + j] = g * __builtin_amdgcn_rcpf(1.f + __expf(-g)) * up; }
                u32x4 w; w.x = cvt_pk_bf16(h[0], h[1]); w.y = cvt_pk_bf16(h[2], h[3]); w.z = cvt_pk_bf16(h[4], h[5]); w.w = cvt_pk_bf16(h[6], h[7]);
                *(u32x4*)(H + (size_t)row * DFF + col0) = w;
            }
    }
};
struct EpiResid {
    static constexpr bool PERM = false, AFTER_DRAIN = false;
    const float* xp; const float* xs; float* Y; bf16_t* XB; float* rowsq_out; float scale; int inplace;
    __device__ __forceinline__ void operator()(const pg8::f32x4 (&acc)[2][2][4][2], const pg8::Unit& u, int wr, int wc, int fr, int fq) const {
        const int row0 = u.pm * 256 + wr * 64 + fr, col0 = u.pn * 256 + wc * 32 + 4 * fq;
#pragma unroll
        for (int ai = 0; ai < 2; ++ai)
#pragma unroll
            for (int m = 0; m < 4; ++m) {
                const int row = row0 + ai * 128 + m * 16;
                float* yo = Y + (size_t)row * DM;
                const float* base = inplace ? yo : (row < TP ? xp + (size_t)row * DM : xs + (size_t)(row - TP) * DM);
                float ss = 0.f;
#pragma unroll
                for (int bj = 0; bj < 2; ++bj)
#pragma unroll
                    for (int n = 0; n < 2; ++n) {
                        const int c = col0 + bj * 128 + n * 16;
                        const f32x4 b = *(const f32x4*)(base + c); const f32x4 o = b + acc[ai][bj][m][n] * scale;
                        *(f32x4*)(yo + c) = o;
                        if (XB) { u32x2 w; w.x = cvt_pk_bf16(o[0], o[1]); w.y = cvt_pk_bf16(o[2], o[3]); *(u32x2*)(XB + (size_t)row * DM + c) = w; }
                        ss += (o[0] * o[0] + o[1] * o[1]) + (o[2] * o[2] + o[3] * o[3]);
                    }
                if (rowsq_out) { ss += __shfl_xor(ss, 16); ss += __shfl_xor(ss, 32); if (fq == 0) atomicAdd(rowsq_out + row, ss); }
            }
    }
};
struct EpiProj {
    static constexpr bool PERM = true, AFTER_DRAIN = false;
    const float* rowsq; unsigned char* ws; float* out; const float *gq, *gk, *bfg;
    __device__ __forceinline__ void operator()(const pg8::f32x4 (&acc)[2][2][4][2], const pg8::Unit& u, int wr, int wc, int fr, int fq) const {
        const int row0 = u.pm * 256 + wr * 64 + fr, pn = u.pn;
        if (pn < 6) {
            const int kind = pn >> 1, head = (pn & 1) * 4 + wc, colh = head * 64 + 8 * fq;
            f32x4 gg[2][2];
#pragma unroll
            for (int bj = 0; bj < 2; ++bj)
#pragma unroll
                for (int n = 0; n < 2; ++n) {
                    gg[bj][n] = (f32x4){1.f, 1.f, 1.f, 1.f};
                    if (kind == 0) gg[bj][n] = *(const f32x4*)(gq + 32 * bj + 8 * fq + 4 * n) * QSCALE;
                    if (kind == 1) gg[bj][n] = *(const f32x4*)(gk + 32 * bj + 8 * fq + 4 * n);
                }
#pragma unroll
            for (int ai = 0; ai < 2; ++ai)
#pragma unroll
                for (int m = 0; m < 4; ++m) {
                    const int row = row0 + ai * 128 + m * 16;
                    const float rs = rsqrtf(rowsq[row] * (1.f / 1024.f) + 1e-6f);
                    f32x4 v[2][2]; float ss = 0.f;
#pragma unroll
                    for (int bj = 0; bj < 2; ++bj)
#pragma unroll
                        for (int n = 0; n < 2; ++n) { v[bj][n] = acc[ai][bj][m][n] * rs; const f32x4 t = v[bj][n]; ss += (t[0] * t[0] + t[1] * t[1]) + (t[2] * t[2] + t[3] * t[3]); }
                    if (kind < 2) {
                        ss += __shfl_xor(ss, 16); ss += __shfl_xor(ss, 32);
                        const float nrm = rsqrtf(ss * (1.f / 64.f) + 1e-6f);
#pragma unroll
                        for (int bj = 0; bj < 2; ++bj)
#pragma unroll
                            for (int n = 0; n < 2; ++n) v[bj][n] = v[bj][n] * nrm * gg[bj][n];
                    }
                    bf16_t* dstb = (bf16_t*)(ws + WS_Q + (size_t)kind * (WS_K - WS_Q)) + (size_t)row * 512 + colh;
#pragma unroll
                    for (int bj = 0; bj < 2; ++bj) {
                        u32x4 w; w.x = cvt_pk_bf16(v[bj][0][0], v[bj][0][1]); w.y = cvt_pk_bf16(v[bj][0][2], v[bj][0][3]); w.z = cvt_pk_bf16(v[bj][1][0], v[bj][1][1]); w.w = cvt_pk_bf16(v[bj][1][2], v[bj][1][3]);
                        *(u32x4*)(dstb + 32 * bj) = w;
                    }
                    if (kind >= 1 && row >= TP) {
                        float* dstf = (row < TP ? out + OFF_KP + (size_t)(kind - 1) * (OFF_VP - OFF_KP) + (size_t)row * 512 : out + OFF_KS + (size_t)(kind - 1) * (OFF_VS - OFF_KS) + (size_t)(row - TP) * 512) + colh;
#pragma unroll
                        for (int bj = 0; bj < 2; ++bj) { *(f32x4*)(dstf + 32 * bj) = v[bj][0]; *(f32x4*)(dstf + 32 * bj + 4) = v[bj][1]; }
                    }
                }
        } else if (pn < 13) {
            const int colr = (pn - 6) * 256 + 64 * wc + 8 * fq;
#pragma unroll
            for (int ai = 0; ai < 2; ++ai)
#pragma unroll
                for (int m = 0; m < 4; ++m) {
                    const int row = row0 + ai * 128 + m * 16;
                    const float rs = rsqrtf(rowsq[row] * (1.f / 1024.f) + 1e-6f);
                    const bool last = (row == TP - 1) || (row >= TP && ((row - TP) & 15) == 15);
                    float* dstf = (row < TP ? out + OFF_SHP : out + OFF_SHS + (size_t)((row - TP) >> 4) * RWP) + colr;
#pragma unroll
                    for (int bj = 0; bj < 2; ++bj) {
                        const f32x4 v0 = acc[ai][bj][m][0] * rs, v1 = acc[ai][bj][m][1] * rs;
                        u32x4 w; w.x = cvt_pk_bf16(v0[0], v0[1]); w.y = cvt_pk_bf16(v0[2], v0[3]); w.z = cvt_pk_bf16(v1[0], v1[1]); w.w = cvt_pk_bf16(v1[2], v1[3]);
                        *(u32x4*)((bf16_t*)(ws + WS_PRW) + (size_t)row * RWP + colr + 32 * bj) = w;
                        if (last) { *(f32x4*)(dstf + 32 * bj) = v0; *(f32x4*)(dstf + 32 * bj + 4) = v1; }
                    }
                }
        } else {
            if (wc == 0 && fq == 0) {
                const f32x4 b0 = *(const f32x4*)(bfg), b1 = *(const f32x4*)(bfg + 4);
#pragma unroll
                for (int ai = 0; ai < 2; ++ai)
#pragma unroll
                    for (int m = 0; m < 4; ++m) {
                        const int row = row0 + ai * 128 + m * 16;
                        const float rs = rsqrtf(rowsq[row] * (1.f / 1024.f) + 1e-6f);
                        const f32x4 z0 = acc[ai][0][m][0] * rs + b0, z1 = acc[ai][0][m][1] * rs + b1;
                        f32x4 l0, l1;
#pragma unroll
                        for (int j = 0; j < 4; ++j) { l0[j] = fminf(z0[j], 0.f) - __logf(1.f + __expf(-fabsf(z0[j]))); l1[j] = fminf(z1[j], 0.f) - __logf(1.f + __expf(-fabsf(z1[j]))); }
                        float* LOGF = (float*)(ws + WS_LOGF); *(f32x4*)(LOGF + (size_t)row * 8) = l0; *(f32x4*)(LOGF + (size_t)row * 8 + 4) = l1;
                        float* dstf = row < TP ? out + OFF_LFP + (size_t)row * 8 : out + OFF_LFS + (size_t)(row - TP) * 8;
                        *(f32x4*)dstf = l0; *(f32x4*)(dstf + 4) = l1;
                    }
            }
        }
    }
};
struct EpiBf16N {
    static constexpr bool PERM = true, AFTER_DRAIN = false;
    bf16_t* O; int ldc;
    __device__ __forceinline__ void operator()(const pg8::f32x4 (&acc)[2][2][4][2], const pg8::Unit& u, int wr, int wc, int fr, int fq) const {
        const int row0 = u.pm * 256 + wr * 64 + fr, col0 = u.pn * 256 + wc * 32 + 8 * fq;
#pragma unroll
        for (int ai = 0; ai < 2; ++ai)
#pragma unroll
            for (int m = 0; m < 4; ++m) {
                bf16_t* rowp = O + (size_t)(row0 + ai * 128 + m * 16) * ldc + col0;
#pragma unroll
                for (int bj = 0; bj < 2; ++bj) {
                    const f32x4 v0 = acc[ai][bj][m][0], v1 = acc[ai][bj][m][1];
                    u32x4 w; w.x = cvt_pk_bf16(v0[0], v0[1]); w.y = cvt_pk_bf16(v0[2], v0[3]); w.z = cvt_pk_bf16(v1[0], v1[1]); w.w = cvt_pk_bf16(v1[2], v1[3]);
                    *(u32x4*)(rowp + bj * 128) = w;
                }
            }
    }
};

__device__ __forceinline__ void phase4(CArgsP a, int wave, int lane) {
    unsigned char* ws = a->ws;
    const bf16_t* PRW = (const bf16_t*)(ws + WS_PRW); bf16_t* LA = (bf16_t*)(ws + WS_LORAA);
    const int gw = blockIdx.x * 8 + wave, NGW = gridDim.x * 8;
    const f32x4 mu = *(const f32x4*)(a->in[16] + 1536 + 4 * lane);
#pragma unroll 8
    for (int m = gw; m < MROWS; m += NGW) {
        const u32x2 pw = *(const u32x2*)(PRW + (size_t)m * RWP + 1536 + 4 * lane);
        f32x4 p = {bf2f(pw.x & 0xffffu), bf2f(pw.x >> 16), bf2f(pw.y & 0xffffu), bf2f(pw.y >> 16)};
        f32x4 q = {0.f, 0.f, 0.f, 0.f};
        const bool first = (m == 0) || (m >= TP && ((m - TP) & 15) == 0);
        if (!first) { const u32x2 qw = *(const u32x2*)(PRW + (size_t)(m - 1) * RWP + 1536 + 4 * lane); q = (f32x4){bf2f(qw.x & 0xffffu), bf2f(qw.x >> 16), bf2f(qw.y & 0xffffu), bf2f(qw.y >> 16)}; }
        else if (m >= TP) q = *(const f32x4*)(a->in[6] + (size_t)((m - TP) >> 4) * RWP + 1536 + 4 * lane);
        const f32x4 xs = p + (q - p) * mu;
        float o[4];
#pragma unroll
        for (int j = 0; j < 4; ++j) { const float e = __expf(lane < 16 ? 2.f * xs[j] : -xs[j]); const float rc = __builtin_amdgcn_rcpf(1.f + e); o[j] = lane < 16 ? 1.f - 2.f * rc : (lane < 32 ? xs[j] : rc); }
        u32x2 w; w.x = pk2(o[0], o[1]); w.y = pk2(o[2], o[3]);
        *(u32x2*)(LA + (size_t)m * KLORA + 4 * lane) = w;
    }
    if (blockIdx.x < 64) {
        const float* LOGF = (const float*)(ws + WS_LOGF); float* CUM = (float*)(ws + WS_CUM); float* TT = (float*)(ws + WS_TT);
        const int tile = blockIdx.x, h = wave, t0 = tile * 256 + 4 * lane;
        float v0 = LOGF[(size_t)(t0 + 0) * 8 + h], v1 = LOGF[(size_t)(t0 + 1) * 8 + h], v2 = LOGF[(size_t)(t0 + 2) * 8 + h], v3 = LOGF[(size_t)(t0 + 3) * 8 + h];
        v1 += v0; v2 += v1; v3 += v2;
        float inc = v3;
#pragma unroll
        for (int o = 1; o < 64; o <<= 1) { const float t = __shfl_up(inc, o); if (lane >= o) inc += t; }
        const float excl = inc - v3;
        CUM[(size_t)(t0 + 0) * 8 + h] = excl + v0; CUM[(size_t)(t0 + 1) * 8 + h] = excl + v1; CUM[(size_t)(t0 + 2) * 8 + h] = excl + v2; CUM[(size_t)(t0 + 3) * 8 + h] = excl + v3;
        if (lane == 63) TT[tile * 8 + h] = inc;
    }
}
__device__ __forceinline__ void cum_fixup(CArgsP a) {
    if (blockIdx.x < 64) {
        float* CUM = (float*)(a->ws + WS_CUM); const float* TT = (const float*)(a->ws + WS_TT);
        const int tile = blockIdx.x, h = threadIdx.x & 7;
        float pre = 0.f;
        for (int t = 0; t < tile; ++t) pre += TT[t * 8 + h];
#pragma unroll
        for (int i = 0; i < 4; ++i) { const int idx = threadIdx.x + 512 * i; CUM[(size_t)tile * 2048 + idx] += pre; }
    }
}

constexpr int AT_KVBUF = 17664, AT_VT = 8192, AT_CK = 17408, AT_MISC = 2 * AT_KVBUF, AT_VS = 144;
__device__ __forceinline__ int slotpos(int kv) { const int w = kv & 15; return (kv & ~15) + 8 * ((w >> 2) & 1) + (w & 3) + ((w >> 3) << 2); }
__device__ __forceinline__ void attn_unit(LAS unsigned char* lds, CArgsP a, int h, int qb, float thr) {
    const int tid = threadIdx.x, lane = tid & 63, wid = tid >> 6, r32 = lane & 31, hi = lane >> 5;
    const bf16_t* QB = (const bf16_t*)(a->ws + WS_Q); const bf16_t* KB = (const bf16_t*)(a->ws + WS_K); const bf16_t* VB = (const bf16_t*)(a->ws + WS_V);
    const float* CUM = (const float*)(a->ws + WS_CUM); bf16_t* MIX = (bf16_t*)(a->ws + WS_XB);
    const int q0 = qb * 256, qrow = q0 + wid * 32 + r32;
    bf16x8 qr[4];
#pragma unroll
    for (int d0 = 0; d0 < 4; ++d0) qr[d0] = *(const bf16x8*)(QB + (size_t)qrow * 512 + h * 64 + d0 * 16 + hi * 8);
    const float cref = CUM[(size_t)q0 * 8 + h];
    const int jt_hi = 4 * qb + 3;
    LAS int* s_lo = (LAS int*)(lds + AT_MISC);
    __syncthreads();
    if (tid == 0) *s_lo = 4 * qb;
    __syncthreads();
    {
        const float cq0 = cref;
        if (tid < 4 * qb) { const float cj = CUM[(size_t)(64 * tid + 63) * 8 + h]; if (cq0 - cj >= -thr) atomicMin((int*)s_lo, tid); }
    }
    __syncthreads();
    const int jt_lo = *s_lo;
    const int kvl = tid & 63, ch = tid >> 6;
    u32x4 kreg, vreg; float ckreg = 0.f;
    auto gload = [&](int jt) {
        const size_t off = (size_t)(64 * jt + kvl) * 512 + h * 64 + ch * 8;
        kreg = *(const u32x4*)(KB + off); vreg = *(const u32x4*)(VB + off);
        if (tid < 64) ckreg = (CUM[(size_t)(64 * jt + tid) * 8 + h] - cref) * LOG2E;
    };
    u32x4 kreg2, vreg2; float ckreg2 = 0.f;
    auto gload2 = [&](int jt) {
        const size_t off = (size_t)(64 * jt + kvl) * 512 + h * 64 + ch * 8;
        kreg2 = *(const u32x4*)(KB + off); vreg2 = *(const u32x4*)(VB + off);
        if (tid < 64) ckreg2 = (CUM[(size_t)(64 * jt + tid) * 8 + h] - cref) * LOG2E;
    };
    const int sp2 = 2 * slotpos(kvl);
    auto lstore = [&](int b) {
        LAS unsigned char* buf = lds + b * AT_KVBUF;
        *(LAS u32x4*)(buf + ch * 1024 + kvl * 16) = kreg;
        LAS unsigned char* vt = buf + AT_VT + (8 * ch) * AT_VS + sp2;
        *(LAS unsigned short*)(vt + 0 * AT_VS) = (unsigned short)(vreg.x & 0xffffu); *(LAS unsigned short*)(vt + 1 * AT_VS) = (unsigned short)(vreg.x >> 16);
        *(LAS unsigned short*)(vt + 2 * AT_VS) = (unsigned short)(vreg.y & 0xffffu); *(LAS unsigned short*)(vt + 3 * AT_VS) = (unsigned short)(vreg.y >> 16);
        *(LAS unsigned short*)(vt + 4 * AT_VS) = (unsigned short)(vreg.z & 0xffffu); *(LAS unsigned short*)(vt + 5 * AT_VS) = (unsigned short)(vreg.z >> 16);
        *(LAS unsigned short*)(vt + 6 * AT_VS) = (unsigned short)(vreg.w & 0xffffu); *(LAS unsigned short*)(vt + 7 * AT_VS) = (unsigned short)(vreg.w >> 16);
        if (tid < 64) *(LAS float*)(buf + AT_CK + 4 * tid) = ckreg;
    };
    gload(jt_hi); lstore(0);
    if (jt_lo < jt_hi) gload(jt_hi - 1);
    __syncthreads();
    float m_run = -INFINITY, l_run = 0.f;
    f32x16 o0 = {}, o1 = {};
    for (int jt = jt_hi; jt >= jt_lo; --jt) {
        const int b = (jt_hi - jt) & 1;
        if (jt - 2 >= jt_lo) gload2(jt - 2);
        LAS unsigned char* buf = lds + b * AT_KVBUF;
        if (64 * (jt - 4 * qb) <= 32 * wid + 31) {
        f32x16 p0 = {}, p1 = {};
#pragma unroll
        for (int d0 = 0; d0 < 4; ++d0) {
            const bf16x8 a0 = *(const LAS bf16x8*)(buf + (2 * d0 + hi) * 1024 + r32 * 16);
            const bf16x8 a1 = *(const LAS bf16x8*)(buf + (2 * d0 + hi) * 1024 + (32 + r32) * 16);
            p0 = __builtin_amdgcn_mfma_f32_32x32x16_bf16(a0, qr[d0], p0, 0, 0, 0);
            p1 = __builtin_amdgcn_mfma_f32_32x32x16_bf16(a1, qr[d0], p1, 0, 0, 0);
        }
        const int kvb = 64 * jt;
        float mx = -INFINITY;
        if (jt < 4 * qb) {
#pragma unroll
            for (int g = 0; g < 4; ++g) {
                const f32x4 c0 = *(const LAS f32x4*)(buf + AT_CK + 4 * (8 * g + 4 * hi));
                const f32x4 c1 = *(const LAS f32x4*)(buf + AT_CK + 4 * (32 + 8 * g + 4 * hi));
#pragma unroll
                for (int j = 0; j < 4; ++j) { const float s0 = p0[4 * g + j] - c0[j], s1 = p1[4 * g + j] - c1[j]; p0[4 * g + j] = s0; p1[4 * g + j] = s1; mx = fmaxf(mx, fmaxf(s0, s1)); }
            }
        } else {
#pragma unroll
            for (int g = 0; g < 4; ++g) {
                const f32x4 c0 = *(const LAS f32x4*)(buf + AT_CK + 4 * (8 * g + 4 * hi));
                const f32x4 c1 = *(const LAS f32x4*)(buf + AT_CK + 4 * (32 + 8 * g + 4 * hi));
#pragma unroll
                for (int j = 0; j < 4; ++j) {
                    const int kv = kvb + 8 * g + 4 * hi + j;
                    float s0 = p0[4 * g + j] - c0[j]; if (kv > qrow) s0 = -INFINITY;
                    float s1 = p1[4 * g + j] - c1[j]; if (kv + 32 > qrow) s1 = -INFINITY;
                    p0[4 * g + j] = s0; p1[4 * g + j] = s1; mx = fmaxf(mx, fmaxf(s0, s1));
                }
            }
        }
        mx = fmaxf(mx, __shfl_xor(mx, 32));
        float ps = 0.f;
        if (__any(mx > m_run)) {
            const float m_new = fmaxf(m_run, mx);
            const float alpha = __builtin_amdgcn_exp2f(m_run - m_new);
            m_run = m_new;
            l_run *= alpha;
#pragma unroll
            for (int r = 0; r < 16; ++r) { o0[r] *= alpha; o1[r] *= alpha; }
        }
#pragma unroll
        for (int r = 0; r < 16; ++r) { p0[r] = __builtin_amdgcn_exp2f(p0[r] - m_run); p1[r] = __builtin_amdgcn_exp2f(p1[r] - m_run); ps += p0[r] + p1[r]; }
        l_run += ps;
        bf16x8 pf[4];
#pragma unroll
        for (int bb = 0; bb < 2; ++bb) {
            u32x4 w0, w1;
            w0.x = cvt_pk_bf16(p0[8 * bb + 0], p0[8 * bb + 1]); w0.y = cvt_pk_bf16(p0[8 * bb + 2], p0[8 * bb + 3]); w0.z = cvt_pk_bf16(p0[8 * bb + 4], p0[8 * bb + 5]); w0.w = cvt_pk_bf16(p0[8 * bb + 6], p0[8 * bb + 7]);
            w1.x = cvt_pk_bf16(p1[8 * bb + 0], p1[8 * bb + 1]); w1.y = cvt_pk_bf16(p1[8 * bb + 2], p1[8 * bb + 3]); w1.z = cvt_pk_bf16(p1[8 * bb + 4], p1[8 * bb + 5]); w1.w = cvt_pk_bf16(p1[8 * bb + 6], p1[8 * bb + 7]);
            pf[bb] = __builtin_bit_cast(bf16x8, w0); pf[2 + bb] = __builtin_bit_cast(bf16x8, w1);
        }
#pragma unroll
        for (int kb = 0; kb < 4; ++kb) {
            const bf16x8 v0 = *(const LAS bf16x8*)(buf + AT_VT + (r32) * AT_VS + (16 * kb + 8 * hi) * 2);
            const bf16x8 v1 = *(const LAS bf16x8*)(buf + AT_VT + (32 + r32) * AT_VS + (16 * kb + 8 * hi) * 2);
            o0 = __builtin_amdgcn_mfma_f32_32x32x16_bf16(v0, pf[kb], o0, 0, 0, 0);
            o1 = __builtin_amdgcn_mfma_f32_32x32x16_bf16(v1, pf[kb], o1, 0, 0, 0);
        }
        }
        if (jt > jt_lo) lstore(b ^ 1);
        asm volatile("s_waitcnt lgkmcnt(0)\n\ts_barrier" ::: "memory");
        kreg = kreg2; vreg = vreg2; ckreg = ckreg2;
    }
    const float lt = l_run + __shfl_xor(l_run, 32);
    const float inv = 1.f / lt;
    bf16_t* orow = MIX + (size_t)qrow * DM + h * 64 + 4 * hi;
#pragma unroll
    for (int g = 0; g < 4; ++g) {
        u32x2 w0, w1;
        w0.x = cvt_pk_bf16(o0[4 * g] * inv, o0[4 * g + 1] * inv); w0.y = cvt_pk_bf16(o0[4 * g + 2] * inv, o0[4 * g + 3] * inv);
        w1.x = cvt_pk_bf16(o1[4 * g] * inv, o1[4 * g + 1] * inv); w1.y = cvt_pk_bf16(o1[4 * g + 2] * inv, o1[4 * g + 3] * inv);
        *(u32x2*)(orow + 8 * g) = w0; *(u32x2*)(orow + 32 + 8 * g) = w1;
    }
}

constexpr int SA_C = 0, SA_Q = 4352, SA_SC = 8448, SA_NK = PAST + TSS;
__device__ __forceinline__ void attn_sample_unit(LAS unsigned char* lds, CArgsP a, int b, int h) {
    const int tid = threadIdx.x, lane = tid & 63, wid = tid >> 6;
    LAS float* C = (LAS float*)(lds + SA_C); LAS float* Qs = (LAS float*)(lds + SA_Q); LAS float* SC = (LAS float*)(lds + SA_SC);
    const float* LOGF = (const float*)(a->ws + WS_LOGF); const bf16_t* QB = (const bf16_t*)(a->ws + WS_Q); bf16_t* MIX = (bf16_t*)(a->ws + WS_XB);
    const float* ck = a->in[2]; const float* cv = a->in[3]; const float* clf = a->in[4];
    const float* nk = a->out + OFF_KS; const float* nv = a->out + OFF_VS;
    __syncthreads();
    if (wid == 0) {
        float v[17]; float run = 0.f;
#pragma unroll
        for (int i = 0; i < 17; ++i) {
            const int j = 17 * lane + i; float x = 0.f;
            if (j < PAST) x = clf[((size_t)b * PAST + j) * 8 + h]; else if (j < SA_NK) x = LOGF[(size_t)(TP + 16 * b + (j - PAST)) * 8 + h];
            run += x; v[i] = run;
        }
        float inc = run;
#pragma unroll
        for (int o = 1; o < 64; o <<= 1) { const float t = __shfl_up(inc, o); if (lane >= o) inc += t; }
        const float excl = inc - run;
#pragma unroll
        for (int i = 0; i < 17; ++i) { const int j = 17 * lane + i; if (j < SA_NK) C[j] = excl + v[i]; }
    } else {
        for (int i = tid - 64; i < 1024; i += 448) { const int t = i >> 6, d = i & 63; Qs[i] = bf2f(QB[(size_t)(TP + 16 * b + t) * 512 + h * 64 + d]); }
    }
    __syncthreads();
    for (int j = tid; j < SA_NK; j += 512) {
        const float* kp = j < PAST ? ck + (((size_t)b * PAST + j) * 8 + h) * 64 : nk + (size_t)(16 * b + (j - PAST)) * 512 + h * 64;
        float acc[16];
#pragma unroll
        for (int t = 0; t < 16; ++t) acc[t] = 0.f;
#pragma unroll
        for (int hb = 0; hb < 2; ++hb) {
            f32x4 kr[8];
#pragma unroll
            for (int i = 0; i < 8; ++i) kr[i] = *(const f32x4*)(kp + 32 * hb + 4 * i);
#pragma unroll
            for (int i = 0; i < 8; ++i) {
                asm volatile("" ::: "memory");
                const f32x4 k4 = kr[i];
#pragma unroll
                for (int t = 0; t < 16; ++t) { const f32x4 q4 = *(const LAS f32x4*)(Qs + t * 64 + 32 * hb + 4 * i); acc[t] += (q4[0] * k4[0] + q4[1] * k4[1]) + (q4[2] * k4[2] + q4[3] * k4[3]); }
            }
        }
        const float cj = C[j];
#pragma unroll
        for (int t = 0; t < 16; ++t) SC[t * SA_NK + j] = acc[t] + (C[PAST + t] - cj) * LOG2E;
    }
    __syncthreads();
#pragma unroll
    for (int tt = 0; tt < 2; ++tt) {
        const int t = 2 * wid + tt; LAS float* row = SC + t * SA_NK;
        float mx = -INFINITY;
        for (int j = lane; j < SA_NK; j += 64) { if (j > PAST + t) row[j] = -INFINITY; mx = fmaxf(mx, row[j]); }
        mx = wave_max(mx);
        float sum = 0.f;
        for (int j = lane; j < SA_NK; j += 64) { const float p = __builtin_amdgcn_exp2f(row[j] - mx); row[j] = p; sum += p; }
        sum = wave_sum(sum);
        const float inv = 1.f / sum;
        for (int j = lane; j < SA_NK; j += 64) row[j] *= inv;
    }
    __syncthreads();
    {
        float acc[16];
#pragma unroll
        for (int t = 0; t < 16; ++t) acc[t] = 0.f;
        const float* vp = cv + ((size_t)b * PAST * 8 + h) * 64 + lane;
        float vv[8], vn8[8];
#pragma unroll
        for (int i = 0; i < 8; ++i) vv[i] = vp[(size_t)(wid + 8 * i) * 512];
#pragma unroll 1
        for (int j0 = wid; j0 < PAST; j0 += 64) {
            const int jn = (j0 + 64 < PAST) ? j0 + 64 : j0;
#pragma unroll
            for (int i = 0; i < 8; ++i) vn8[i] = vp[(size_t)(jn + 8 * i) * 512];
#pragma unroll
            for (int i = 0; i < 8; ++i) {
                asm volatile("" ::: "memory");
#pragma unroll
                for (int t = 0; t < 16; ++t) acc[t] += SC[t * SA_NK + j0 + 8 * i] * vv[i];
            }
#pragma unroll
            for (int i = 0; i < 8; ++i) vv[i] = vn8[i];
        }
        {
            const float* vn = nv + (size_t)(16 * b) * 512 + h * 64 + lane;
            const float v0 = vn[(size_t)wid * 512], v1 = vn[(size_t)(wid + 8) * 512];
#pragma unroll
            for (int t = 0; t < 16; ++t) acc[t] += SC[t * SA_NK + PAST + wid] * v0 + SC[t * SA_NK + PAST + wid + 8] * v1;
        }
        __syncthreads();
        LAS float* red = SC;
#pragma unroll
        for (int t = 0; t < 16; ++t) red[(wid * 16 + t) * 64 + lane] = acc[t];
        __syncthreads();
        {
            const int t = tid >> 5, d = 2 * (tid & 31);
            float a0 = 0.f, a1 = 0.f;
#pragma unroll
            for (int w = 0; w < 8; ++w) { a0 += red[(w * 16 + t) * 64 + d]; a1 += red[(w * 16 + t) * 64 + d + 1]; }
            *(unsigned*)(MIX + (size_t)(TP + 16 * b + t) * DM + h * 64 + d) = pk2(a0, a1);
        }
    }
}

constexpr int NSEG = 64, SEGCH = TP / 16 / NSEG;
constexpr size_t WS_PM = WS_SEG, WS_UM = WS_W1I, WS_SS = WS_LORAA;
constexpr int SC_CHB = 7 * 16 * 64 * 4, SC_Y = 2 * SC_CHB, SC_HALF = SC_Y + 16 * 64 * 4;
static_assert(2 * SC_HALF <= 131072, "scan LDS");
__device__ __forceinline__ float wave_sum_fast(float x) {
    x += dpp_f<0xB1>(x); x += dpp_f<0x4E>(x); x += dpp_f<0x141>(x); x += dpp_f<0x140>(x);
    x += __builtin_bit_cast(float, __builtin_amdgcn_update_dpp(0, __builtin_bit_cast(int, x), 0x142, 0xa, 0xf, false));
    x += __builtin_bit_cast(float, __builtin_amdgcn_update_dpp(0, __builtin_bit_cast(int, x), 0x143, 0xc, 0xf, false));
    return __builtin_bit_cast(float, __builtin_amdgcn_readlane(__builtin_bit_cast(int, x), 63));
}
struct ScanRaw { unsigned prk[4], pvq[4], qkv[4], lwa[4]; unsigned short lg[4]; };
struct ScanUnit { int seq, h, c0; const float* S0; float* Sout; float* Pout; };
typedef float f32x2 __attribute__((ext_vector_type(2)));
struct V8 { f32x2 p[4]; };
__device__ __forceinline__ V8 ld8(const LAS float* p) {
    const f32x4 a = *(const LAS f32x4*)p, b = *(const LAS f32x4*)(p + 4);
    V8 r; r.p[0] = __builtin_shufflevector(a, a, 0, 1); r.p[1] = __builtin_shufflevector(a, a, 2, 3); r.p[2] = __builtin_shufflevector(b, b, 0, 1); r.p[3] = __builtin_shufflevector(b, b, 2, 3); return r;
}
__device__ __forceinline__ float dot8(const V8& S, const V8& k) { f32x2 acc = S.p[0] * k.p[0]; acc = S.p[1] * k.p[1] + acc; acc = S.p[2] * k.p[2] + acc; acc = S.p[3] * k.p[3] + acc; return acc.x + acc.y; }
__device__ __forceinline__ float red8(float d) { d += dpp_f<0xB1>(d); d += dpp_f<0x4E>(d); d += dpp_f<0x141>(d); return d; }
__device__ __forceinline__ void upd8(V8& S, const V8& w, const V8& b, const V8& k, float sa, float vv) {
    const f32x2 sa2 = {sa, sa}, vv2 = {vv, vv};
#pragma unroll
    for (int i = 0; i < 4; ++i) { f32x2 t = vv2 * k.p[i]; t = sa2 * b.p[i] + t; S.p[i] = S.p[i] * w.p[i] + t; }
}
__device__ __forceinline__ void updp8(V8& S, const V8& w, const V8& b, float sa) {
    const f32x2 sa2 = {sa, sa};
#pragma unroll
    for (int i = 0; i < 4; ++i) { const f32x2 t = sa2 * b.p[i]; S.p[i] = S.p[i] * w.p[i] + t; }
}
template <int MODE>
__device__ __forceinline__ void scan_pair(LAS unsigned char* lds, CArgsP a, const ScanUnit u, int nch) {
    const int tid = threadIdx.x, lane = tid & 63, wid = tid >> 6, half = wid >> 2, hw = wid & 3, ks = lane & 7, vr0 = hw * 16 + (lane >> 3), vr1 = vr0 + 8;
    LAS unsigned char* hl = lds + half * SC_HALF;
    const bf16_t* PRW = (const bf16_t*)(a->ws + WS_PRW); const bf16_t* LORA = (const bf16_t*)(a->ws + WS_LORA); bf16_t* MIX = (bf16_t*)(a->ws + WS_XB);
    const int seq = u.seq, h = u.h, c0 = u.c0;
    const int rowbase = seq == 0 ? 0 : TP + 16 * (seq - 1);
    const int c_ = h * 64 + lane;
    const float mu_r = a->in[16][c_], mu_k = a->in[16][512 + c_], mu_v = a->in[16][1024 + c_], w0c = a->in[17][c_], a0c = a->in[19][c_];
    const float kkc = a->in[22][c_], kac = a->in[23][c_], rkc = a->in[24][c_], lng = a->in[25][c_], lnb = a->in[26][c_];
    V8 Sa, Sb, Pa, Pb;
#pragma unroll
    for (int i = 0; i < 4; ++i) {
        Sa.p[i] = (f32x2){0.f, 0.f}; Sb.p[i] = (f32x2){0.f, 0.f};
        Pa.p[i] = (f32x2){(8 * ks + 2 * i == vr0) ? 1.f : 0.f, (8 * ks + 2 * i + 1 == vr0) ? 1.f : 0.f};
        Pb.p[i] = (f32x2){(8 * ks + 2 * i == vr1) ? 1.f : 0.f, (8 * ks + 2 * i + 1 == vr1) ? 1.f : 0.f};
    }
    if (u.S0) {
        const float* sp = u.S0 + (size_t)vr0 * 64 + 8 * ks;
        const f32x4 s0 = *(const f32x4*)sp, s1 = *(const f32x4*)(sp + 4), s2 = *(const f32x4*)(sp + 512), s3 = *(const f32x4*)(sp + 516);
        Sa.p[0] = (f32x2){s0[0], s0[1]}; Sa.p[1] = (f32x2){s0[2], s0[3]}; Sa.p[2] = (f32x2){s1[0], s1[1]}; Sa.p[3] = (f32x2){s1[2], s1[3]};
        Sb.p[0] = (f32x2){s2[0], s2[1]}; Sb.p[1] = (f32x2){s2[2], s2[3]}; Sb.p[2] = (f32x2){s3[0], s3[1]}; Sb.p[3] = (f32x2){s3[2], s3[3]};
    }
    __syncthreads();
    ScanRaw R;
    float sh0[3];
    auto rawload = [&](int c) {
#pragma unroll
        for (int tt = 0; tt < 4; ++tt) {
            const int tl = 16 * c + 4 * hw + tt; const size_t m = (size_t)rowbase + tl;
            const unsigned pr = PRW[m * RWP + c_], pk = PRW[m * RWP + 512 + c_], pv = PRW[m * RWP + 1024 + c_];
            unsigned qr = 0, qk = 0, qv = 0;
            if (tl > 0) { qr = PRW[(m - 1) * RWP + c_]; qk = PRW[(m - 1) * RWP + 512 + c_]; qv = PRW[(m - 1) * RWP + 1024 + c_]; }
            else {
                sh0[0] = 0.f; sh0[1] = 0.f; sh0[2] = 0.f;
                if (seq > 0) { const float* s0 = a->in[6] + (size_t)(seq - 1) * RWP; sh0[0] = s0[c_]; sh0[1] = s0[512 + c_]; sh0[2] = s0[1024 + c_]; }
            }
            const unsigned lw = LORA[m * NLORA + c_], la = LORA[m * NLORA + 512 + c_];
            R.prk[tt] = pr | (pk << 16); R.pvq[tt] = pv | (qr << 16); R.qkv[tt] = qk | (qv << 16); R.lwa[tt] = lw | (la << 16);
            R.lg[tt] = LORA[m * NLORA + 1024 + c_];
        }
    };
    auto prep = [&](int c, int b) {
        LAS float* cb = (LAS float*)(hl + b * SC_CHB);
#pragma unroll
        for (int tt = 0; tt < 4; ++tt) {
            const int t = 4 * hw + tt, tl = 16 * c + t;
            const float pr = bf2f(R.prk[tt] & 0xffffu), pk = bf2f(R.prk[tt] >> 16), pv = bf2f(R.pvq[tt] & 0xffffu);
            float qr = bf2f(R.pvq[tt] >> 16), qk = bf2f(R.qkv[tt] & 0xffffu), qv = bf2f(R.qkv[tt] >> 16);
            if (tl == 0) { qr = sh0[0]; qk = sh0[1]; qv = sh0[2]; }
            const float xr = pr + (qr - pr) * mu_r, xk = pk + (qk - pk) * mu_k, xv = pv + (qv - pv) * mu_v;
            const float wp = w0c + bf2f(R.lwa[tt] & 0xffffu);
            const float w = __expf(-0.6065306597126334f * __builtin_amdgcn_rcpf(1.f + __expf(-wp)));
            const float av = __builtin_amdgcn_rcpf(1.f + __expf(-(a0c + bf2f(R.lwa[tt] >> 16))));
            float kk = xk * kkc;
            const float n2 = wave_sum_fast(kk * kk);
            kk = kk * rsqrtf(fmaxf(n2, 1e-24f));
            const float kp = xk * (1.f + (av - 1.f) * kac);
            cb[(0 * 16 + t) * 64 + lane] = w; cb[(1 * 16 + t) * 64 + lane] = kk; cb[(2 * 16 + t) * 64 + lane] = kk * av; cb[(3 * 16 + t) * 64 + lane] = kp;
            cb[(4 * 16 + t) * 64 + lane] = xr; cb[(5 * 16 + t) * 64 + lane] = xv; cb[(6 * 16 + t) * 64 + lane] = bf2f(R.lg[tt]);
        }
    };
    rawload(c0); prep(c0, 0);
    __syncthreads();
    LAS float* Y = (LAS float*)(hl + SC_Y);
    for (int ci = 0; ci < nch; ++ci) {
        const int b = ci & 1, c = c0 + ci;
        if (ci + 1 < nch) rawload(c + 1);
        const LAS float* cb = (const LAS float*)(hl + b * SC_CHB);
#pragma unroll 8
        for (int t = 0; t < 16; ++t) {
            const LAS float* p = cb + t * 64 + 8 * ks;
            const V8 w = ld8(p), kk = ld8(p + 1024), bb = ld8(p + 2048), kv = ld8(p + 3072);
            const float va = cb[(5 * 16 + t) * 64 + vr0], vb = cb[(5 * 16 + t) * 64 + vr1];
            float da = dot8(Sa, kk), db = dot8(Sb, kk);
            da = red8(da); db = red8(db);
            upd8(Sa, w, bb, kv, -da, va); upd8(Sb, w, bb, kv, -db, vb);
            if (MODE == 1) {
                float pa = dot8(Pa, kk), pb = dot8(Pb, kk);
                pa = red8(pa); pb = red8(pb);
                updp8(Pa, w, bb, -pa); updp8(Pb, w, bb, -pb);
            } else {
                const V8 rr = ld8(p + 4096);
                float ya = dot8(Sa, rr), yb = dot8(Sb, rr);
                ya = red8(ya); yb = red8(yb);
                if (ks == 0) { Y[t * 64 + vr0] = ya; Y[t * 64 + vr1] = yb; }
            }
        }
        __syncthreads();
        if (MODE == 0) {
#pragma unroll
            for (int tt = 0; tt < 4; ++tt) {
                const int t = 4 * hw + tt; const size_t m = (size_t)rowbase + 16 * c + t;
                const float y = Y[t * 64 + lane];
                const float mean = wave_sum_fast(y) * (1.f / 64.f); const float dv = y - mean;
                const float var = wave_sum_fast(dv * dv) * (1.f / 64.f);
                const float yn = dv * rsqrtf(var + 64e-5f) * lng + lnb;
                const float r = cb[(4 * 16 + t) * 64 + lane], kp = cb[(3 * 16 + t) * 64 + lane], v = cb[(5 * 16 + t) * 64 + lane], g = cb[(6 * 16 + t) * 64 + lane];
                const float rk = wave_sum_fast(r * kp * rkc);
                MIX[m * DM + 512 + c_] = (bf16_t)f2bf((yn + rk * v) * g);
            }
        }
        if (ci + 1 < nch) prep(c + 1, b ^ 1);
        __syncthreads();
    }
    if (u.Sout) {
        float* so = u.Sout + (size_t)vr0 * 64 + 8 * ks;
        *(f32x4*)so = (f32x4){Sa.p[0].x, Sa.p[0].y, Sa.p[1].x, Sa.p[1].y}; *(f32x4*)(so + 4) = (f32x4){Sa.p[2].x, Sa.p[2].y, Sa.p[3].x, Sa.p[3].y};
        *(f32x4*)(so + 512) = (f32x4){Sb.p[0].x, Sb.p[0].y, Sb.p[1].x, Sb.p[1].y}; *(f32x4*)(so + 516) = (f32x4){Sb.p[2].x, Sb.p[2].y, Sb.p[3].x, Sb.p[3].y};
    }
    if (MODE == 1) {
        float* po = u.Pout + (size_t)vr0 * 64 + 8 * ks;
        *(f32x4*)po = (f32x4){Pa.p[0].x, Pa.p[0].y, Pa.p[1].x, Pa.p[1].y}; *(f32x4*)(po + 4) = (f32x4){Pa.p[2].x, Pa.p[2].y, Pa.p[3].x, Pa.p[3].y};
        *(f32x4*)(po + 512) = (f32x4){Pb.p[0].x, Pb.p[0].y, Pb.p[1].x, Pb.p[1].y}; *(f32x4*)(po + 516) = (f32x4){Pb.p[2].x, Pb.p[2].y, Pb.p[3].x, Pb.p[3].y};
    }
}
__device__ __forceinline__ void scan_combine(LAS unsigned char* lds, CArgsP a) {
    if (blockIdx.x >= 64) return;
    const int tid = threadIdx.x, h = blockIdx.x >> 3, rw = tid >> 6, v = (blockIdx.x & 7) * 8 + rw, kq = tid & 63;
    const float* PM = (const float*)(a->ws + WS_PM); const float* UM = (const float*)(a->ws + WS_UM); float* SS = (float*)(a->ws + WS_SS);
    LAS float* Sl = (LAS float*)lds;
    LAS float* Pl = (LAS float*)(lds + 4096);
    constexpr int GL = NSEG - 2;
    float cur = SS[((size_t)(1 * 8 + h) * 64 + v) * 64 + kq];
    f32x4 pa, pb;
    float u1, u2;
    {
        const f32x4* P1 = (const f32x4*)(PM + (size_t)(1 * 8 + h) * 4096);
        *(LAS f32x4*)(Pl + 1 * 4096 + 4 * tid) = P1[tid]; *(LAS f32x4*)(Pl + 1 * 4096 + 2048 + 4 * tid) = P1[512 + tid];
        if (GL >= 2) { const f32x4* P2 = (const f32x4*)(PM + (size_t)(2 * 8 + h) * 4096);
            *(LAS f32x4*)(Pl + 2 * 4096 + 4 * tid) = P2[tid]; *(LAS f32x4*)(Pl + 2 * 4096 + 2048 + 4 * tid) = P2[512 + tid]; }
        u1 = UM[((size_t)(1 * 8 + h) * 64 + v) * 64 + kq];
        u2 = GL >= 2 ? UM[((size_t)(2 * 8 + h) * 64 + v) * 64 + kq] : 0.f;
    }
    for (int g = 1; g <= GL; ++g) {
        const bool pf = (g + 2 <= GL);
        float u3 = 0.f;
        if (pf) { const f32x4* Pn = (const f32x4*)(PM + (size_t)((g + 2) * 8 + h) * 4096); pa = Pn[tid]; pb = Pn[512 + tid]; u3 = UM[((size_t)((g + 2) * 8 + h) * 64 + v) * 64 + kq]; }
        asm volatile("s_waitcnt lgkmcnt(0)\n\ts_barrier" ::: "memory");
        const LAS float* Pg = Pl + (g % 3) * 4096 + kq;
        float acc0 = u1, acc1 = 0.f, acc2 = 0.f, acc3 = 0.f;
        const int curi = __builtin_bit_cast(int, cur);
#pragma unroll
        for (int k = 0; k < 64; k += 4) {
            const float s0 = __builtin_bit_cast(float, __builtin_amdgcn_readlane(curi, k)), s1 = __builtin_bit_cast(float, __builtin_amdgcn_readlane(curi, k + 1));
            const float s2 = __builtin_bit_cast(float, __builtin_amdgcn_readlane(curi, k + 2)), s3 = __builtin_bit_cast(float, __builtin_amdgcn_readlane(curi, k + 3));
            acc0 += s0 * Pg[(k + 0) * 64]; acc1 += s1 * Pg[(k + 1) * 64]; acc2 += s2 * Pg[(k + 2) * 64]; acc3 += s3 * Pg[(k + 3) * 64];
        }
        cur = (acc0 + acc1) + (acc2 + acc3);
        SS[((size_t)((g + 1) * 8 + h) * 64 + v) * 64 + kq] = cur;
        if (pf) { LAS float* dst = Pl + ((g + 2) % 3) * 4096; *(LAS f32x4*)(dst + 4 * tid) = pa; *(LAS f32x4*)(dst + 2048 + 4 * tid) = pb; }
        u1 = u2; u2 = u3;
    }
}

constexpr size_t WS_BAR = 512 * 1024, BAR_BYTES = 16 * 1024;
constexpr int LDS_MISC = 131072 + 64;
#define XB_TMO      128
#define XB_XCNT(j)  (256  + 64 * (j))
#define XB_XSUB(j)  (1280 + 64 * (j))
#define XB_XGEN(j)  (2304 + 64 * (j))
#define XB_TOP      3328
#define XB_TOPGEN   3392
#define XCD_BAR_WORDS 3456
#define XB_SPIN_CAP (1u << 18)

__device__ __forceinline__ unsigned xb_ld(unsigned* p)              { return __hip_atomic_load(p, __ATOMIC_RELAXED, __HIP_MEMORY_SCOPE_AGENT); }
__device__ __forceinline__ unsigned xb_add(unsigned* p, unsigned v) { return __hip_atomic_fetch_add(p, v, __ATOMIC_RELAXED, __HIP_MEMORY_SCOPE_AGENT); }
__device__ __forceinline__ unsigned xb_xcc_id() { return (unsigned)__builtin_amdgcn_s_getreg((3 << 11) | 20) & 0xFu; }
#define XB_SPIN(cond, bar) do { unsigned _sp = 0; while (cond) { __builtin_amdgcn_s_sleep(1); \
    if ((++_sp & 255u) == 0u) { if (xb_ld(&(bar)[XB_TMO])) break; if (_sp > XB_SPIN_CAP) { atomicAdd(&(bar)[XB_TMO], 1u); break; } } } } while (0)

struct XcdBarrier {
    unsigned* bar; unsigned x;
    volatile LAS unsigned* st;
};

__device__ __forceinline__ XcdBarrier xcd_barrier_post(unsigned* bar, volatile LAS unsigned* st) {
    XcdBarrier b; b.bar = bar; b.x = xb_xcc_id(); b.st = st;
    if (threadIdx.x == 0) (void)xb_add(&bar[XB_XCNT(b.x)], 1u);
    return b;
}
__device__ __forceinline__ void xcd_barrier_complete(unsigned* bar, unsigned x, unsigned& nloc, unsigned& nx) {
    const unsigned G = gridDim.x * gridDim.y * gridDim.z;
    unsigned sum, cnt, mine, sp = 0u;
    for (;;) {
        sum = 0u; cnt = 0u; mine = 0u;
#pragma unroll
        for (unsigned j = 0; j < 16; ++j) { const unsigned c = xb_ld(&bar[XB_XCNT(j)]); sum += c; cnt += (c > 0u) ? 1u : 0u; mine = (j == x) ? c : mine; }
        if (sum == G) break;
        __builtin_amdgcn_s_sleep(1);
        if ((++sp & 255u) == 0u) { if (xb_ld(&bar[XB_TMO])) break; if (sp > XB_SPIN_CAP) { atomicAdd(&bar[XB_TMO], 1u); break; } }
    }
    nloc = mine > 0u ? mine : 1u; nx = cnt > 0u ? cnt : 1u;
}

__device__ __forceinline__ void xcd_barrier(const XcdBarrier& b) {
    asm volatile("s_waitcnt vmcnt(0)" ::: "memory");
    __syncthreads();
    if (threadIdx.x == 0) {
        unsigned* bar = b.bar;
        __builtin_amdgcn_s_waitcnt(0);
        unsigned nloc = b.st[0], nx = b.st[1];
        if (nloc == 0u) { xcd_barrier_complete(bar, b.x, nloc, nx); b.st[0] = nloc; b.st[1] = nx; }
        const unsigned old = xb_add(&bar[XB_XSUB(b.x)], 1u);
        const unsigned gen = old / nloc;
        if (old + 1u == (gen + 1u) * nloc) {
            __builtin_amdgcn_fence(__ATOMIC_RELEASE, "agent");
            asm volatile("s_waitcnt vmcnt(0)" ::: "memory");
            const unsigned og = xb_add(&bar[XB_TOP], 1u);
            const unsigned tg = og / nx;
            if (og + 1u == (tg + 1u) * nx) xb_add(&bar[XB_TOPGEN], 1u);
            else XB_SPIN(xb_ld(&bar[XB_TOPGEN]) == tg, bar);
            __builtin_amdgcn_fence(__ATOMIC_ACQUIRE, "agent");
            xb_add(&bar[XB_XGEN(b.x)], 1u);
            asm volatile("s_waitcnt vmcnt(0)" ::: "memory");
        } else {
            XB_SPIN(xb_ld(&bar[XB_XGEN(b.x)]) == gen, bar);
            __builtin_amdgcn_fence(__ATOMIC_ACQUIRE, "agent");
            asm volatile("s_waitcnt vmcnt(0)" ::: "memory");
        }
    }
    __syncthreads();
}

__device__ __forceinline__ void grid_bar(LAS unsigned char* lds) {
    CArgsP a = get_args(); XcdBarrier b; b.bar = (unsigned*)(a->ws + WS_BAR); b.x = xb_xcc_id(); b.st = (volatile LAS unsigned*)(lds + LDS_MISC);
    xcd_barrier(b);
}

constexpr int CNT_FFN1 = 3840, CNT_FFN2 = 3904;
struct SampleFirstOrder {
    int nM, nN, nwg, G, c, nS; unsigned* cnt;
    __device__ void init(int M, int N, int G_, int c_, unsigned* cnt_) { nM = M / 256; nN = N / 256; nwg = nM * nN; G = G_; c = c_; nS = nN; cnt = cnt_; }
    __device__ bool next(int i, pg8::Unit& u) const {
        long L = (long)i * G + c;
        if (G == 256 && nN == 22) {
            if (c >= G - 4) { if (i >= 3) return false; }
            else if (c >= G - 12 && i == 5) { const int k = c - (G - 12); L = (long)(3 + (k >> 2)) * G + (G - 4 + (k & 3)); }
        }
        if (L < nS) { u.pm = nM; u.pn = (int)L; return true; }
        L -= nS; if (L >= nwg) return false;
        int wgid = (int)L; { const int q = nwg / pg8::NXCD, r = nwg % pg8::NXCD, xcd = wgid % pg8::NXCD, off = wgid / pg8::NXCD; wgid = (xcd < r ? xcd * (q + 1) : r * (q + 1) + (xcd - r) * q) + off; }
        const int nig = pg8::WGM * nN, gid = wgid / nig, fm = gid * pg8::WGM, gsz = (nM - fm) < pg8::WGM ? (nM - fm) : pg8::WGM;
        u.pm = fm + ((wgid % nig) % gsz); u.pn = (wgid % nig) / gsz; return true;
    }
    __device__ __forceinline__ void a_ready(const pg8::Unit&) const {}
    __device__ __forceinline__ void done(const pg8::Unit& u) const {
        if (u.pm == nM) { __builtin_amdgcn_fence(__ATOMIC_RELEASE, "agent"); if ((threadIdx.x & 63) == 0) __hip_atomic_fetch_add(cnt, 1u, __ATOMIC_RELAXED, __HIP_MEMORY_SCOPE_AGENT); }
    }
};
struct OneUnit {
    int pm, pn;
    __device__ bool next(int i, pg8::Unit& u) const { if (i) return false; u.pm = pm; u.pn = pn; return true; }
    __device__ __forceinline__ void a_ready(const pg8::Unit&) const {}
    __device__ __forceinline__ void done(const pg8::Unit&) const {}
};
__device__ __forceinline__ void wait_count(unsigned* cnt, unsigned want) {
    if (threadIdx.x == 0) {
        unsigned sp = 0;
        while (__hip_atomic_load(cnt, __ATOMIC_RELAXED, __HIP_MEMORY_SCOPE_AGENT) < want && ++sp < (1u << 24)) __builtin_amdgcn_s_sleep(2);
        __builtin_amdgcn_fence(__ATOMIC_ACQUIRE, "agent");
        asm volatile("s_waitcnt vmcnt(0)" ::: "memory");
    }
    __syncthreads();
}

__device__ __forceinline__ void expand_kv(CArgsP a, int r0, int nr) {
    const bf16_t* KB = (const bf16_t*)(a->ws + WS_K); const bf16_t* VB = (const bf16_t*)(a->ws + WS_V);
    float* ok = a->out + OFF_KP; float* ov = a->out + OFF_VP;
    const size_t base = (size_t)r0 * 512; const int n8 = nr * 64;
#pragma unroll 4
    for (int c = threadIdx.x; c < n8; c += 512) {
        const size_t e = base + (size_t)c * 8;
        const u32x4 kw = *(const u32x4*)(KB + e), vw = *(const u32x4*)(VB + e);
        *(f32x4*)(ok + e) = (f32x4){bf2f(kw.x & 0xffffu), bf2f(kw.x >> 16), bf2f(kw.y & 0xffffu), bf2f(kw.y >> 16)};
        *(f32x4*)(ok + e + 4) = (f32x4){bf2f(kw.z & 0xffffu), bf2f(kw.z >> 16), bf2f(kw.w & 0xffffu), bf2f(kw.w >> 16)};
        *(f32x4*)(ov + e) = (f32x4){bf2f(vw.x & 0xffffu), bf2f(vw.x >> 16), bf2f(vw.y & 0xffffu), bf2f(vw.y >> 16)};
        *(f32x4*)(ov + e + 4) = (f32x4){bf2f(vw.z & 0xffffu), bf2f(vw.z >> 16), bf2f(vw.w & 0xffffu), bf2f(vw.w >> 16)};
    }
}

#ifdef PROBE_PHASE
__device__ __forceinline__ int probe_reps(int k) { int n = (k == PROBE_PHASE) ? 2 : 1; asm volatile("" : "+s"(n)); return n; }
#define PH(k) for (int r_ = 0, n_ = probe_reps(k); r_ < n_; ++r_)
#else
#define PH(k)
#endif
constexpr int LDS_BYTES = 136 * 1024;
__global__ void __launch_bounds__(512, 2) mega_fwd(Args a_unused) {
    extern __shared__ __attribute__((aligned(16))) unsigned char lds_raw[];
    cg::grid_group grid = cg::this_grid();
    LAS unsigned char* lds = (LAS unsigned char*)lds_raw;
    const int tid = threadIdx.x, lane = tid & 63, wave = __builtin_amdgcn_readfirstlane(tid >> 6);
    const int G = gridDim.x, bx = blockIdx.x;
    if (tid < 64) ((LAS unsigned*)(lds + 131072))[tid] = 0u;
    __syncthreads();

    { CArgsP a = get_args(); phase0(a, lds, wave, lane);
      if (bx == 0) { unsigned* bw = (unsigned*)(a->ws + WS_BAR); for (int i = tid; i < (int)(BAR_BYTES / 4); i += 512) bw[i] = 0u; } }
    grid.sync();
    { CArgsP a = get_args(); (void)xcd_barrier_post((unsigned*)(a->ws + WS_BAR), (volatile LAS unsigned*)(lds + LDS_MISC)); }
    PH(1) { CArgsP a = get_args(); unsigned char* ws = a->ws; unsigned* cnt = (unsigned*)(ws + WS_BAR) + CNT_FFN1;
      { pg8::Gemm g{(const bf16_t*)(ws + WS_XB), (const bf16_t*)(ws + WS_W1I), MROWS, 2 * DFF, DM}; SampleFirstOrder S; S.init(TP, 2 * DFF, G, bx, cnt);
        EpiSwiglu E{(bf16_t*)(ws + WS_H), (const float*)(ws + WS_ROWSQ0)}; pg8::gemm_phase<EpiSwiglu, SampleFirstOrder, true, true>(lds, g, S, E); }
      if (bx >= G - 4) {
        wait_count(cnt, 8u * (2 * DFF / 256));
        pg8::Gemm g{(const bf16_t*)(ws + WS_H), (const bf16_t*)(ws + WS_W1O), MROWS, DM, DFF}; OneUnit S{TP / 256, bx - (G - 4)};
        EpiResid E{a->in[0], a->in[1], a->out, (bf16_t*)(ws + WS_XB), (float*)(ws + WS_ROWSQ1), 0.5f, 0}; pg8::gemm_phase<EpiResid, OneUnit, true, true>(lds, g, S, E); } }
    grid_bar(lds);
    PH(2) { CArgsP a = get_args(); unsigned char* ws = a->ws;
      pg8::Gemm g{(const bf16_t*)(ws + WS_H), (const bf16_t*)(ws + WS_W1O), TP, DM, DFF}; pg8::StaticOrder S; S.init(TP, DM, G, bx);
      EpiResid E{a->in[0], a->in[1], a->out, (bf16_t*)(ws + WS_XB), (float*)(ws + WS_ROWSQ1), 0.5f, 0}; pg8::gemm_phase<EpiResid, pg8::StaticOrder, true, true>(lds, g, S, E); }
    grid_bar(lds);
    PH(3) { CArgsP a = get_args(); unsigned char* ws = a->ws;
      pg8::Gemm g{(const bf16_t*)(ws + WS_XB), (const bf16_t*)(ws + WS_WIN), MROWS, NPROJ, DM}; pg8::StaticOrder S; S.init(MROWS, NPROJ, G, bx);
      EpiProj E{(const float*)(ws + WS_ROWSQ1), ws, a->out, a->in[14], a->in[15], a->in[13]};
      pg8::gemm_phase<EpiProj, pg8::StaticOrder, true, true>(lds, g, S, E); }
    grid_bar(lds);
    PH(4) { CArgsP a = get_args(); phase4(a, wave, lane); }
    grid_bar(lds);
    { CArgsP a = get_args(); cum_fixup(a); }
    PH(5) { CArgsP a = get_args(); unsigned char* ws = a->ws;

      int kl = KLORA; asm volatile("" : "+s"(kl));
      pg8::Gemm g{(const bf16_t*)(ws + WS_LORAA), (const bf16_t*)(ws + WS_WLORA), MROWS, NLORA, kl}; pg8::StaticOrder S; S.init(MROWS, NLORA, G, bx);
      EpiBf16N E{(bf16_t*)(ws + WS_LORA), NLORA}; pg8::gemm_phase<EpiBf16N, pg8::StaticOrder, true, true>(lds, g, S, E); }
    grid_bar(lds);
    PH(6) {
        CArgsP a = get_args();
        float gqm = 0.f, gkm = 0.f;
        { const float gq = fabsf(a->in[14][lane]), gk = fabsf(a->in[15][lane]); gqm = wave_max(gq); gkm = wave_max(gk); }
        const float thr = 30.f + 16.f * gqm * gkm;
        float* SS = (float*)(a->ws + WS_SS); float* PM = (float*)(a->ws + WS_PM); float* UM = (float*)(a->ws + WS_UM);
        const int half = tid >> 8;
        constexpr int NUPP = 4 * (NSEG - 2), NSC = 4 + NUPP;
        PH(10) for (int it = bx; it < NSC; it += G) {
            if (it < 4) { const int hh = 2 * it + half; ScanUnit u{0, hh, 0, nullptr, SS + (size_t)(1 * 8 + hh) * 4096, nullptr}; scan_pair<0>(lds, a, u, SEGCH); }
            else { const int uu = 2 * (it - 4) + half, g = 1 + (uu >> 3), hh = uu & 7;
                ScanUnit u{0, hh, g * SEGCH, nullptr, UM + (size_t)(g * 8 + hh) * 4096, PM + (size_t)(g * 8 + hh) * 4096}; scan_pair<1>(lds, a, u, SEGCH); }
        }
        if (G == 256) {
            int a0, an;
            if (bx >= 252) { a0 = 500 + 3 * (bx - 252); an = 3; } else if (bx >= 4) { a0 = 2 * (bx - 4); an = 2; } else { a0 = 496 + bx; an = 1; }
            PH(11) for (int it = a0; it < a0 + an; ++it) attn_unit(lds, a, it & 7, 63 - (it >> 3), thr);
        } else {
            for (int it = (bx + G - NSC % G) % G; it < 512; it += G) attn_unit(lds, a, it & 7, 63 - (it >> 3), thr);
        }
        if (G != 256) for (int it = G - 1 - bx; it < 128; it += G) attn_sample_unit(lds, a, it >> 3, it & 7);
        if (G != 256) for (int it = ((G - 129 - bx) % G + G) % G; it < 64; it += G) {
            const int uu = 2 * it + half, sb = uu >> 3, hh = uu & 7;
            ScanUnit u{1 + sb, hh, 0, a->in[5] + (size_t)(sb * 8 + hh) * 4096, a->out + OFF_STS + (size_t)(sb * 8 + hh) * 4096, nullptr}; scan_pair<0>(lds, a, u, 1);
        }
    }
    grid_bar(lds);
    PH(7) { CArgsP a = get_args(); if (bx < 64 || G <= 64) scan_combine(lds, a); __syncthreads(); if (bx >= 64 || G <= 64) convert_weights(a, lds, wave, lane, 1, G <= 64 ? bx : bx - 64, G <= 64 ? G : G - 64); if (G == 256 && bx >= 64 && bx < 192) attn_sample_unit(lds, a, (bx - 64) >> 3, (bx - 64) & 7);
      if (G == 256 && bx >= 192) {
          const int uu = 2 * (bx - 192) + (tid >> 8), sb = uu >> 3, hh = uu & 7;
          ScanUnit u{1 + sb, hh, 0, a->in[5] + (size_t)(sb * 8 + hh) * 4096, a->out + OFF_STS + (size_t)(sb * 8 + hh) * 4096, nullptr}; scan_pair<0>(lds, a, u, 1);
          expand_kv(a, (bx - 192) * 256, 256);
      }
      if (G != 256) { const int per = (TP + G - 1) / G; const int r0 = bx * per; if (r0 < TP) expand_kv(a, r0, (r0 + per <= TP) ? per : TP - r0); } }
    grid_bar(lds);
    PH(8) { CArgsP a = get_args();
      float* SS = (float*)(a->ws + WS_SS);
      const int half = tid >> 8;
      PH(14) for (int it = bx; it < 4 * (NSEG - 1); it += G) {
          const int uu = 2 * it + half, g = 1 + (uu >> 3), hh = uu & 7;
          ScanUnit u{0, hh, g * SEGCH, SS + (size_t)(g * 8 + hh) * 4096, g == NSEG - 1 ? a->out + OFF_STP + (size_t)hh * 4096 : nullptr, nullptr};
          scan_pair<0>(lds, a, u, SEGCH);
      }
      if (bx >= G - 4) {
        unsigned char* ws = a->ws;
        pg8::Gemm g{(const bf16_t*)(ws + WS_XB), (const bf16_t*)(ws + WS_WOUT), MROWS, DM, DM}; OneUnit S{TP / 256, bx - (G - 4)};
        EpiResid E{nullptr, nullptr, a->out, (bf16_t*)(ws + WS_X2B), (float*)(ws + WS_ROWSQ2), 1.0f, 1}; pg8::gemm_phase<EpiResid, OneUnit, true, true>(lds, g, S, E); }
    }
    grid_bar(lds);
    { CArgsP a = get_args(); unsigned char* ws = a->ws;
      pg8::Gemm g{(const bf16_t*)(ws + WS_XB), (const bf16_t*)(ws + WS_WOUT), TP, DM, DM}; pg8::StaticOrder S; S.init(TP, DM, G, bx);
      EpiResid E{nullptr, nullptr, a->out, (bf16_t*)(ws + WS_X2B), (float*)(ws + WS_ROWSQ2), 1.0f, 1}; pg8::gemm_phase<EpiResid, pg8::StaticOrder, true, true>(lds, g, S, E); }
    grid_bar(lds);
    PH(9) { CArgsP a = get_args(); unsigned char* ws = a->ws; unsigned* cnt = (unsigned*)(ws + WS_BAR) + CNT_FFN2;
      { pg8::Gemm g{(const bf16_t*)(ws + WS_X2B), (const bf16_t*)(ws + WS_W2I), MROWS, 2 * DFF, DM}; SampleFirstOrder S; S.init(TP, 2 * DFF, G, bx, cnt);
        EpiSwiglu E{(bf16_t*)(ws + WS_H), (const float*)(ws + WS_ROWSQ2)}; pg8::gemm_phase<EpiSwiglu, SampleFirstOrder, true, true>(lds, g, S, E); }
      if (bx >= G - 4) {
        wait_count(cnt, 8u * (2 * DFF / 256));
        pg8::Gemm g{(const bf16_t*)(ws + WS_H), (const bf16_t*)(ws + WS_W2O), MROWS, DM, DFF}; OneUnit S{TP / 256, bx - (G - 4)};
        EpiResid E{nullptr, nullptr, a->out, nullptr, nullptr, 0.5f, 1}; pg8::gemm_phase<EpiResid, OneUnit, true, true>(lds, g, S, E); } }
    grid_bar(lds);
    { CArgsP a = get_args(); unsigned char* ws = a->ws;
      pg8::Gemm g{(const bf16_t*)(ws + WS_H), (const bf16_t*)(ws + WS_W2O), TP, DM, DFF}; pg8::StaticOrder S; S.init(TP, DM, G, bx);
      EpiResid E{nullptr, nullptr, a->out, nullptr, nullptr, 0.5f, 1}; pg8::gemm_phase<EpiResid, pg8::StaticOrder, true, true>(lds, g, S, E); }
}

extern "C" void kernel_launch(void* const* d_in, const int* in_sizes, int n_in, void* d_out, int out_size, void* d_ws, size_t ws_size, hipStream_t stream) {
    static int grid = 0;
    if (grid == 0) {
        if (n_in != 30 || out_size != (int)OUT_TOTAL || ws_size < WS_END || in_sizes[0] != TP * DM) { fprintf(stderr, "kernel_launch: unexpected shapes (n_in %d out %d ws %zu)\n", n_in, out_size, ws_size); grid = -1; return; }
        int dev = 0, cus = 0, per_cu = 0;
        if (hipGetDevice(&dev) != hipSuccess || hipDeviceGetAttribute(&cus, hipDeviceAttributeMultiprocessorCount, dev) != hipSuccess) { grid = -1; return; }
        if (hipFuncSetAttribute((const void*)mega_fwd, hipFuncAttributeMaxDynamicSharedMemorySize, LDS_BYTES) != hipSuccess) { fprintf(stderr, "kernel_launch: hipFuncSetAttribute failed\n"); grid = -1; return; }
        if (hipOccupancyMaxActiveBlocksPerMultiprocessor(&per_cu, (const void*)mega_fwd, 512, LDS_BYTES) != hipSuccess || per_cu < 1) { fprintf(stderr, "kernel_launch: occupancy query failed (%d)\n", per_cu); (void)hipGetLastError(); grid = -1; return; }
        grid = cus * per_cu;
    }
    if (grid < 64) return;
    Args a{};
    for (int i = 0; i < 30; ++i) a.in[i] = (const float*)d_in[i];
    a.out = (float*)d_out; a.ws = (unsigned char*)d_ws;
    void* args[] = {&a};
    hipError_t e = hipLaunchCooperativeKernel((const void*)mega_fwd, dim3(grid), dim3(512), args, LDS_BYTES, stream);
    if (e != hipSuccess) fprintf(stderr, "kernel_launch: cooperative launch failed: %s (grid %d)\n", hipGetErrorString(e), grid);
}
```

```cpp
#include <hip/hip_runtime.h>
#include <hip/hip_cooperative_groups.h>
#include <cstdio>
#include <cstdint>
namespace cg = cooperative_groups;
namespace pg8 {
#define PG8_LAS __attribute__((address_space(3)))
typedef unsigned short bf16_t;
typedef short bf16x8 __attribute__((ext_vector_type(8)));
typedef float f32x4 __attribute__((ext_vector_type(4)));
typedef unsigned u32x4 __attribute__((ext_vector_type(4)));
constexpr int BM = 256, BK = 64, HALF = 128, HTB = HALF * BK * 2  , STAGE_BYTES = 8 * HTB, NXCD = 8, WGM = 8;

__host__ __device__ __forceinline__ int lds_byte(int r, int c) { const int st = (r >> 4) * 2 + (c >> 5), rr = r & 15, cc = c & 31, ob = rr * 64 + cc * 2; return st * 1024 + (ob ^ (((ob >> 9) & 1) << 5)); }
__host__ __device__ __forceinline__ void stage_rc(int b, int& R, int& C) { const int st = b / 1024, sb = b % 1024, swz = sb ^ (((sb >> 9) & 1) << 5); R = (st >> 1) * 16 + swz / 64; C = (st & 1) * 32 + (swz % 64) / 2; }
__host__ __device__ __forceinline__ int perm32(int rho) { const int n = rho >> 4, i = rho & 15; return 8 * (i >> 2) + 4 * n + (i & 3); }

struct Unit { int pm, pn; };
struct Gemm { const bf16_t* A; const bf16_t* Bt; int M, N, K; };

struct StaticOrder {
    int nM, nN, nwg, G, c;
    __host__ __device__ void init(int M, int N, int G_, int c_) { nM = M / BM; nN = N / BM; nwg = nM * nN; G = G_; c = c_; }
    __host__ __device__ bool next(int i, Unit& u) const {
        const long L = (long)i * G + c; if (L >= nwg) return false;
        int wgid = (int)L; { const int q = nwg / NXCD, r = nwg % NXCD, xcd = wgid % NXCD, off = wgid / NXCD; wgid = (xcd < r ? xcd * (q + 1) : r * (q + 1) + (xcd - r) * q) + off; }
        const int nig = WGM * nN, gid = wgid / nig, fm = gid * WGM, gsz = (nM - fm) < WGM ? (nM - fm) : WGM;
        u.pm = fm + ((wgid % nig) % gsz); u.pn = (wgid % nig) / gsz; return true;
    }
    __device__ __forceinline__ void a_ready(const Unit&) const {}
    __device__ __forceinline__ void done(const Unit&) const {}
};

__device__ __forceinline__ unsigned cvt_pk_bf16(float lo, float hi) { unsigned r; asm volatile("v_cvt_pk_bf16_f32 %0, %1, %2" : "=v"(r) : "v"(lo), "v"(hi)); return r; }
template <class Epi, class Sched, bool ALIGN_EPI = false, bool SP2 = false>
__device__ __forceinline__ void gemm_phase(PG8_LAS unsigned char* lds, const Gemm g, const Sched& S, const Epi& E) {
    int tid_l = threadIdx.x; asm volatile("" : "+v"(tid_l));
    const int tid = tid_l, wid = __builtin_amdgcn_readfirstlane(tid >> 6), lane = tid & 63, wr = wid >> 2, wc = wid & 3, fr = lane & 15, fq = lane >> 4;
    const int K = g.K, nt = K / BK;
    unsigned voffA[2], voffB[2];
#pragma unroll
    for (int i = 0; i < 2; ++i) { int R, C; stage_rc(tid * 16 + i * 8192, R, C); const int Rb = Epi::PERM ? ((R & ~31) + perm32(R & 31)) : R;
        voffA[i] = (unsigned)(R * K + C) * 2u; voffB[i] = (unsigned)(Rb * K + C) * 2u; }
    const size_t kstep = (size_t)(BK * 2);
    const size_t hstep = (size_t)HALF * K * 2;
    const size_t tstep = 2 * hstep;
    const unsigned ldsw = (unsigned)wid * 1024u;
    const int aoff = lds_byte(wr * 64 + fr, fq * 8), boff = lds_byte(wc * 32 + fr, fq * 8);
#define PG8_SA(b, h) (((b) * 2 + (h)) * HTB)
#define PG8_SB(b, h) ((4 + (b) * 2 + (h)) * HTB)
#define PG8_STAGE(bufoff, gbase, voff) do { _Pragma("unroll") for (int _i = 0; _i < 2; ++_i) \
        __builtin_amdgcn_global_load_lds((const unsigned*)((const char*)(gbase) + (voff)[_i]), (PG8_LAS unsigned*)(lds + (bufoff) + ldsw + _i * 8192), 16, 0, 0); } while (0)
#define PG8_LDA(dst, b, h) do { _Pragma("unroll") for (int m = 0; m < 4; ++m) _Pragma("unroll") for (int k = 0; k < 2; ++k) dst[m][k] = *(const PG8_LAS bf16x8*)(lds + PG8_SA(b, h) + aoff + m * 2048 + k * 1024); } while (0)
#define PG8_LDB(dst, b, h) do { _Pragma("unroll") for (int n = 0; n < 2; ++n) _Pragma("unroll") for (int k = 0; k < 2; ++k) dst[n][k] = *(const PG8_LAS bf16x8*)(lds + PG8_SB(b, h) + boff + n * 2048 + k * 1024); } while (0)
#define PG8_MMA(ai, bj, At, Bt) do { __builtin_amdgcn_s_setprio(1); _Pragma("unroll") for (int m = 0; m < 4; ++m) _Pragma("unroll") for (int n = 0; n < 2; ++n) _Pragma("unroll") for (int k = 0; k < 2; ++k) \
        acc[ai][bj][m][n] = __builtin_amdgcn_mfma_f32_16x16x32_bf16(Bt[n][k], At[m][k], acc[ai][bj][m][n], 0, 0, 0); __builtin_amdgcn_s_setprio(0); } while (0)
#define PG8_WAIT_V(n) asm volatile("s_waitcnt vmcnt(" #n ")" ::: "memory")
#define PG8_WAIT_L(n) asm volatile("s_waitcnt lgkmcnt(" #n ")" ::: "memory")
#define PG8_BAR __builtin_amdgcn_s_barrier()
#define PG8_SCHED __builtin_amdgcn_sched_barrier(0)
    Unit cur, nxt; int ui = 0;
    if (!S.next(0, cur)) return;
    f32x4 acc[2][2][4][2];
#pragma unroll
    for (int a = 0; a < 2; ++a)
#pragma unroll
        for (int b = 0; b < 2; ++b)
#pragma unroll
            for (int m = 0; m < 4; ++m)
#pragma unroll
                for (int n = 0; n < 2; ++n) acc[a][b][m][n] = (f32x4){0.f, 0.f, 0.f, 0.f};
    bf16x8 At[4][2], B0[2][2], B1[2][2];
    const char* cA = (const char*)g.A + (size_t)cur.pm * tstep; const char* cB = (const char*)g.Bt + (size_t)cur.pn * tstep;
    S.a_ready(cur);
    if constexpr (SP2) {
        PG8_STAGE(PG8_SB(0, 0), cB, voffB); PG8_STAGE(PG8_SB(0, 1), cB + hstep, voffB); PG8_STAGE(PG8_SA(0, 0), cA, voffA); PG8_STAGE(PG8_SA(0, 1), cA + hstep, voffA);
        if (wr == 1) PG8_BAR;
        PG8_WAIT_V(2); PG8_BAR;
        PG8_STAGE(PG8_SB(1, 0), cB + kstep, voffB); PG8_STAGE(PG8_SA(1, 0), cA + kstep, voffA); PG8_STAGE(PG8_SB(1, 1), cB + hstep + kstep, voffB);
        PG8_WAIT_V(6); PG8_BAR;
    } else {
        PG8_STAGE(PG8_SB(0, 0), cB, voffB); PG8_STAGE(PG8_SA(0, 0), cA, voffA); PG8_STAGE(PG8_SB(0, 1), cB + hstep, voffB); PG8_STAGE(PG8_SA(0, 1), cA + hstep, voffA);
        if (wr == 1) PG8_BAR;
        PG8_WAIT_V(4); PG8_BAR;
        PG8_STAGE(PG8_SB(1, 0), cB + kstep, voffB); PG8_STAGE(PG8_SA(1, 0), cA + kstep, voffA); PG8_STAGE(PG8_SB(1, 1), cB + hstep + kstep, voffB);
        PG8_WAIT_V(6); PG8_BAR;
    }
    for (;;) {
        const bool has_next = S.next(ui + 1, nxt);
        const char* nA = has_next ? (const char*)g.A + (size_t)nxt.pm * tstep : cA; const char* nB = has_next ? (const char*)g.Bt + (size_t)nxt.pn * tstep : cB;
        for (int t = 0; t < nt; t += 2) {
            const bool last = (t == nt - 2);
            const char* a1 = cA + (size_t)(t + 1) * kstep;
            const char* a2 = last ? nA : cA + (size_t)(t + 2) * kstep; const char* b2 = last ? nB : cB + (size_t)(t + 2) * kstep;
            const char* a3 = a2 + kstep; const char* b3 = b2 + kstep;
            if (last && has_next) S.a_ready(nxt);
            if constexpr (SP2) {
            PG8_LDB(B0, 0, 0); PG8_LDB(B1, 0, 1); PG8_SCHED; PG8_LDA(At, 0, 0); PG8_STAGE(PG8_SA(1, 1), a1 + hstep, voffA);
            PG8_WAIT_V(8); PG8_WAIT_L(0); PG8_BAR; PG8_MMA(0, 0, At, B0); PG8_MMA(0, 1, At, B1); PG8_BAR; PG8_SCHED;
            PG8_LDA(At, 0, 1); PG8_STAGE(PG8_SB(0, 0), b2, voffB); PG8_STAGE(PG8_SB(0, 1), b2 + hstep, voffB); PG8_STAGE(PG8_SA(0, 0), a2, voffA);
            PG8_WAIT_V(8); PG8_WAIT_L(0); PG8_BAR; PG8_MMA(1, 0, At, B0); PG8_MMA(1, 1, At, B1); PG8_BAR; PG8_SCHED;
            PG8_LDB(B0, 1, 0); PG8_LDB(B1, 1, 1); PG8_SCHED; PG8_LDA(At, 1, 0); PG8_STAGE(PG8_SA(0, 1), a2 + hstep, voffA);
            PG8_WAIT_V(8); PG8_WAIT_L(0); PG8_BAR; PG8_MMA(0, 0, At, B0); PG8_MMA(0, 1, At, B1); PG8_BAR; PG8_SCHED;
            PG8_LDA(At, 1, 1); PG8_STAGE(PG8_SB(1, 0), b3, voffB); PG8_STAGE(PG8_SB(1, 1), b3 + hstep, voffB); PG8_STAGE(PG8_SA(1, 0), a3, voffA);
            PG8_WAIT_V(8); PG8_WAIT_L(0); PG8_BAR; PG8_MMA(1, 0, At, B0); PG8_MMA(1, 1, At, B1); PG8_BAR; PG8_SCHED;
            } else {
            PG8_LDB(B0, 0, 0); PG8_SCHED; PG8_LDA(At, 0, 0); PG8_STAGE(PG8_SA(1, 1), a1 + hstep, voffA);
            PG8_WAIT_L(8); PG8_BAR; PG8_WAIT_L(0); PG8_MMA(0, 0, At, B0); PG8_BAR; PG8_SCHED;
            PG8_LDB(B1, 0, 1); PG8_STAGE(PG8_SB(0, 0), b2, voffB);
            PG8_BAR; PG8_WAIT_L(0); PG8_MMA(0, 1, At, B1); PG8_BAR;
            PG8_LDA(At, 0, 1); PG8_STAGE(PG8_SA(0, 0), a2, voffA);
            PG8_BAR; PG8_WAIT_L(0); PG8_MMA(1, 0, At, B0); PG8_BAR; PG8_SCHED;
            PG8_STAGE(PG8_SB(0, 1), b2 + hstep, voffB);
            PG8_WAIT_V(6); PG8_BAR; PG8_MMA(1, 1, At, B1); PG8_BAR;
            PG8_LDB(B0, 1, 0); PG8_SCHED; PG8_LDA(At, 1, 0); PG8_STAGE(PG8_SA(0, 1), a2 + hstep, voffA);
            PG8_WAIT_L(8); PG8_BAR; PG8_WAIT_L(0); PG8_MMA(0, 0, At, B0); PG8_BAR; PG8_SCHED;
            PG8_LDB(B1, 1, 1); PG8_STAGE(PG8_SB(1, 0), b3, voffB);
            PG8_BAR; PG8_WAIT_L(0); PG8_MMA(0, 1, At, B1); PG8_BAR;
            PG8_LDA(At, 1, 1); PG8_STAGE(PG8_SA(1, 0), a3, voffA);
            PG8_BAR; PG8_WAIT_L(0); PG8_MMA(1, 0, At, B0); PG8_BAR; PG8_SCHED;
            PG8_STAGE(PG8_SB(1, 1), b3 + hstep, voffB);
            PG8_WAIT_V(6); PG8_BAR; PG8_MMA(1, 1, At, B1); PG8_BAR;
            }
        }
        if constexpr (ALIGN_EPI) { if (wr == 0) PG8_BAR; }
        if constexpr (!Epi::AFTER_DRAIN) { E(acc, cur, wr, wc, fr, fq); S.done(cur); }
        if (!has_next) break;
#pragma unroll
        for (int a = 0; a < 2; ++a)
#pragma unroll
            for (int b = 0; b < 2; ++b)
#pragma unroll
                for (int m = 0; m < 4; ++m)
#pragma unroll
                    for (int n = 0; n < 2; ++n) acc[a][b][m][n] = (f32x4){0.f, 0.f, 0.f, 0.f};
        cur = nxt; cA = nA; cB = nB; ++ui;
        if constexpr (ALIGN_EPI) { if (wr == 1) PG8_BAR; }
    }
    PG8_WAIT_V(0);
    if constexpr (!ALIGN_EPI) { if (wr == 0) PG8_BAR; }
    PG8_BAR;
    if constexpr (Epi::AFTER_DRAIN) { E.fused(acc, cur, wr, wc, fr, fq, lds, wid, lane); S.done(cur); }
#undef PG8_SA
#undef PG8_SB
#undef PG8_STAGE
#undef PG8_LDA
#undef PG8_LDB
#undef PG8_MMA
#undef PG8_WAIT_V
#undef PG8_WAIT_L
#undef PG8_BAR
#undef PG8_SCHED
}
}
#define LAS __attribute__((address_space(3)))
typedef unsigned short bf16_t;
typedef float f32x4 __attribute__((ext_vector_type(4)));
typedef float f32x16 __attribute__((ext_vector_type(16)));
typedef unsigned u32x4 __attribute__((ext_vector_type(4)));
typedef unsigned u32x2 __attribute__((ext_vector_type(2)));
typedef short bf16x8 __attribute__((ext_vector_type(8)));

constexpr int TP = 16384, NSB = 16, TSS = 16, PAST = 1024, MROWS = 16640, DM = 1024, DFF = 2816, NPROJ = 3584, RWP = 1792, NLORA = 1536, KLORA = 256;
constexpr float LOG2E = 1.4426950408889634f;
constexpr float QSCALE = 0.125f * LOG2E;
constexpr size_t OFF_KP = 17039360, OFF_VP = 25427968, OFF_LFP = 33816576, OFF_STP = 33947648, OFF_SHP = 33980416, OFF_KS = 33982208, OFF_VS = 34113280,
                 OFF_LFS = 34244352, OFF_STS = 34246400, OFF_SHS = 34770688, OUT_TOTAL = 34799360;
constexpr size_t MiB = 1u << 20;
constexpr size_t WS_ROWSQ0 = 0, WS_ROWSQ1 = 128 * 1024, WS_ROWSQ2 = 256 * 1024, WS_TT = 384 * 1024;
constexpr size_t WS_LOGF = 1 * MiB, WS_CUM = 2 * MiB;
constexpr size_t WS_W1I = 3 * MiB, WS_W1O = 14 * MiB, WS_WIN = 20 * MiB, WS_WOUT = 27 * MiB, WS_W2I = 29 * MiB, WS_W2O = 40 * MiB, WS_WLORA = 46 * MiB;
constexpr size_t WS_XB = 47 * MiB;
constexpr size_t WS_Q = 80 * MiB, WS_K = 97 * MiB, WS_V = 114 * MiB;
constexpr size_t WS_X2B = 80 * MiB;
constexpr size_t WS_H = 131 * MiB;
constexpr size_t WS_PRW = 131 * MiB, WS_LORAA = 188 * MiB, WS_LORA = 197 * MiB;
constexpr size_t WS_SEG = 246 * MiB, WS_END = 256 * MiB;

struct Args { const float* in[30]; float* out; unsigned char* ws; };
typedef const __attribute__((address_space(4))) Args* CArgsP;
__device__ __forceinline__ CArgsP get_args() { CArgsP p = (CArgsP)__builtin_amdgcn_kernarg_segment_ptr(); asm volatile("" : "+s"(p)); return p; }

#define LDS_WAIT() asm volatile("s_waitcnt lgkmcnt(0)" ::: "memory")
__device__ __forceinline__ unsigned f2bf(float f) { unsigned u = __builtin_bit_cast(unsigned, f); return (u + 0x7fffu + ((u >> 16) & 1u)) >> 16; }
__device__ __forceinline__ unsigned pk2(float lo, float hi) { return f2bf(lo) | (f2bf(hi) << 16); }
__device__ __forceinline__ float bf2f(unsigned b) { return __builtin_bit_cast(float, b << 16); }
__device__ __forceinline__ float wave_sum(float v) {
#pragma unroll
    for (int o = 1; o < 64; o <<= 1) v += __shfl_xor(v, o);
    return v;
}
__device__ __forceinline__ float wave_max(float v) {
#pragma unroll
    for (int o = 1; o < 64; o <<= 1) v = fmaxf(v, __shfl_xor(v, o));
    return v;
}
template <int CTRL> __device__ __forceinline__ float dpp_f(float x) { return __builtin_bit_cast(float, __builtin_amdgcn_mov_dpp(__builtin_bit_cast(int, x), CTRL, 0xf, 0xf, true)); }
__device__ __forceinline__ float allred8(float x) { x += dpp_f<0xB1>(x); x += dpp_f<0x4E>(x); x += dpp_f<0x141>(x); return x; }

__device__ __forceinline__ void p0_item(const float* __restrict__ W, int K, int ldn, int nsrc0, int nvalid, const float* __restrict__ gain, bf16_t* WT, int dstrow0, int k0, LAS float* scr, int lane) {
    const int col = lane & 31;
#pragma unroll
    for (int i = 0; i < 32; ++i) {
        const int kk = 2 * i + (lane >> 5);
        float v = 0.f;
        if (col < nvalid) { v = W[(size_t)(k0 + kk) * ldn + nsrc0 + col]; if (gain) v *= gain[k0 + kk]; }
        scr[kk * 33 + col] = v;
    }
    LDS_WAIT();
    const int c = lane & 7;
#pragma unroll
    for (int j = 0; j < 4; ++j) {
        const int n = (lane >> 3) + 8 * j; const LAS float* s = scr + (8 * c) * 33 + n;
        u32x4 o; o.x = pk2(s[0 * 33], s[1 * 33]); o.y = pk2(s[2 * 33], s[3 * 33]); o.z = pk2(s[4 * 33], s[5 * 33]); o.w = pk2(s[6 * 33], s[7 * 33]);
        *(u32x4*)(WT + (size_t)(dstrow0 + n) * K + k0 + 8 * c) = o;
    }
    LDS_WAIT();
}

__device__ __forceinline__ void convert_tile(const float* __restrict__ W, int K, int ldn, const float* __restrict__ gain, bf16_t* WT, int pn, int k0, int kind, LAS unsigned char* lds, int wave, int lane) {
    LAS float* T = (LAS float*)lds;
    const int c = 4 * lane, q = c >> 5, db = 8 * pn + q;
    int nsrc0, nvalid = 32;
    if (kind == 0) nsrc0 = (q >> 2) * DFF + 128 * pn + 32 * (q & 3);
    else if (kind == 1) nsrc0 = 32 * db;
    else { const int l = 256 * pn + 64 * (q & 3) + 32 * (q >> 2); if (l < 1536) nsrc0 = l; else if (l < 3328) nsrc0 = l + 8; else { nsrc0 = 1536; nvalid = (l == 3328) ? 8 : 0; } }
    const bool ok = (c & 31) < nvalid;
    __syncthreads();
    f32x4 v[8];
#pragma unroll
    for (int i = 0; i < 8; ++i) { const int kk = 8 * wave + i; v[i] = (f32x4){0.f, 0.f, 0.f, 0.f}; if (ok) v[i] = *(const f32x4*)(W + (size_t)(k0 + kk) * ldn + nsrc0 + (c & 31)); }
#pragma unroll
    for (int i = 0; i < 8; ++i) { const int kk = 8 * wave + i; f32x4 t = v[i]; if (gain) t = t * gain[k0 + kk]; *(LAS f32x4*)(T + kk * 260 + c) = t; }
    __syncthreads();
    const int tid = wave * 64 + lane, n = tid & 255, hf = tid >> 8;
    u32x4 o[4];
#pragma unroll
    for (int j = 0; j < 4; ++j) {
        const LAS float* sp = T + (32 * hf + 8 * j) * 260 + n;
        o[j].x = pk2(sp[0 * 260], sp[1 * 260]); o[j].y = pk2(sp[2 * 260], sp[3 * 260]); o[j].z = pk2(sp[4 * 260], sp[5 * 260]); o[j].w = pk2(sp[6 * 260], sp[7 * 260]);
    }
    u32x4* dst = (u32x4*)(WT + (size_t)(256 * pn + n) * K + k0 + 32 * hf);
#pragma unroll
    for (int j = 0; j < 4; ++j) dst[j] = o[j];
}
__device__ __forceinline__ void convert_weights(CArgsP a, LAS unsigned char* lds, int wave, int lane, int which, int gb, int NGB) {
    unsigned char* ws = a->ws;
    constexpr int I0 = 22 * 16, I1 = 4 * 44, I2 = 14 * 16, I3 = 4 * 16;
    const int NIT = which == 0 ? I0 + I1 + I2 : I0 + I1 + I3;
    for (int it = gb; it < NIT; it += NGB) {
        int r = it;
        if (r < I0) { const int pn = r >> 4, kb = r & 15;
            convert_tile(which == 0 ? a->in[8] : a->in[28], 1024, 5632, which == 0 ? a->in[7] : a->in[27], (bf16_t*)(ws + (which == 0 ? WS_W1I : WS_W2I)), pn, 64 * kb, 0, lds, wave, lane); continue; }
        r -= I0;
        if (r < I1) { const int pn = r / 44, kb = r % 44; convert_tile(which == 0 ? a->in[9] : a->in[29], DFF, 1024, nullptr, (bf16_t*)(ws + (which == 0 ? WS_W1O : WS_W2O)), pn, 64 * kb, 1, lds, wave, lane); continue; }
        r -= I1;
        if (which == 0) { const int pn = r >> 4, kb = r & 15; convert_tile(a->in[11], 1024, 3336, a->in[10], (bf16_t*)(ws + WS_WIN), pn, 64 * kb, 2, lds, wave, lane); }
        else { const int pn = r >> 4, kb = r & 15; convert_tile(a->in[12], 1024, 1024, nullptr, (bf16_t*)(ws + WS_WOUT), pn, 64 * kb, 1, lds, wave, lane); }
    }
    __syncthreads();
}
__device__ __forceinline__ void phase0(CArgsP a, LAS unsigned char* lds, int wave, int lane) {
    const int gw = blockIdx.x * 8 + wave, NGW = gridDim.x * 8;
    unsigned char* ws = a->ws;
    convert_weights(a, lds, wave, lane, 0, blockIdx.x, gridDim.x);
    {
        bf16_t* WL = (bf16_t*)(ws + WS_WLORA);
        const int gt = blockIdx.x * 512 + threadIdx.x, NG = gridDim.x * 512;
        for (int idx = gt; idx < NLORA * KLORA; idx += NG) {
            const int n = idx >> 8, k = idx & 255; float v = 0.f;
            if (n < 512) { if (k < 64) v = a->in[18][k * 512 + n]; }
            else if (n < 1024) { if (k >= 64 && k < 128) v = a->in[20][(k - 64) * 512 + (n - 512)]; }
            else { if (k >= 128) v = a->in[21][(k - 128) * 512 + (n - 1024)]; }
            WL[idx] = (bf16_t)f2bf(v);
        }
    }
    {
        bf16_t* XB = (bf16_t*)(ws + WS_XB); float* rq0 = (float*)(ws + WS_ROWSQ0); float* rq1 = (float*)(ws + WS_ROWSQ1); float* rq2 = (float*)(ws + WS_ROWSQ2);
#pragma unroll 2
        for (int m = gw; m < MROWS; m += NGW) {
            const float* xrow = m < TP ? a->in[0] + (size_t)m * DM : a->in[1] + (size_t)(m - TP) * DM;
            const f32x4* xr = (const f32x4*)xrow + lane; f32x4 v[4]; float s = 0.f;
#pragma unroll
            for (int j = 0; j < 4; ++j) { v[j] = xr[64 * j]; s += (v[j].x * v[j].x + v[j].y * v[j].y) + (v[j].z * v[j].z + v[j].w * v[j].w); }
            s = wave_sum(s);
            u32x2* o8 = (u32x2*)(XB + (size_t)m * DM) + lane;
#pragma unroll
            for (int j = 0; j < 4; ++j) { u32x2 w; w.x = pk2(v[j].x, v[j].y); w.y = pk2(v[j].z, v[j].w); o8[64 * j] = w; }
            if (lane == 0) { rq0[m] = s; rq1[m] = 0.f; rq2[m] = 0.f; }
        }
    }
}

using pg8::cvt_pk_bf16;
struct EpiSwiglu {
    static constexpr bool PERM = true, AFTER_DRAIN = false;
    bf16_t* H; const float* rowsq;
    __device__ __forceinline__ void operator()(const pg8::f32x4 (&acc)[2][2][4][2], const pg8::Unit& u, int wr, int wc, int fr, int fq) const {
        const int row0 = u.pm * 256 + wr * 64 + fr, col0 = u.pn * 128 + wc * 32 + 8 * fq;
#pragma unroll
        for (int ai = 0; ai < 2; ++ai)
#pragma unroll
            for (int m = 0; m < 4; ++m) {
                const int row = row0 + ai * 128 + m * 16;
                const float rs = rsqrtf(rowsq[row] * (1.f / 1024.f) + 1e-6f);
                float h[8];
#pragma unroll
                for (int n = 0; n < 2; ++n)
#pragma unroll
                    for (int j = 0; j < 4; ++j) { const float g = acc[ai][0][m][n][j] * rs, up = acc[ai][1][m][n][j] * rs; h[4 * n + j] = g * __builtin_amdgcn_rcpf(1.f + __expf(-g)) * up; }
                u32x4 w; w.x = cvt_pk_bf16(h[0], h[1]); w.y = cvt_pk_bf16(h[2], h[3]); w.z = cvt_pk_bf16(h[4], h[5]); w.w = cvt_pk_bf16(h[6], h[7]);
                *(u32x4*)(H + (size_t)row * DFF + col0) = w;
            }
    }
};
struct EpiResid {
    static constexpr bool PERM = false, AFTER_DRAIN = false;
    const float* xp; const float* xs; float* Y; bf16_t* XB; float* rowsq_out; float scale; int inplace;
    __device__ __forceinline__ void operator()(const pg8::f32x4 (&acc)[2][2][4][2], const pg8::Unit& u, int wr, int wc, int fr, int fq) const {
        const int row0 = u.pm * 256 + wr * 64 + fr, col0 = u.pn * 256 + wc * 32 + 4 * fq;
#pragma unroll
        for (int ai = 0; ai < 2; ++ai)
#pragma unroll
            for (int m = 0; m < 4; ++m) {
                const int row = row0 + ai * 128 + m * 16;
                float* yo = Y + (size_t)row * DM;
                const float* base = inplace ? yo : (row < TP ? xp + (size_t)row * DM : xs + (size_t)(row - TP) * DM);
                float ss = 0.f;
#pragma unroll
                for (int bj = 0; bj < 2; ++bj)
#pragma unroll
                    for (int n = 0; n < 2; ++n) {
                        const int c = col0 + bj * 128 + n * 16;
                        const f32x4 b = *(const f32x4*)(base + c); const f32x4 o = b + acc[ai][bj][m][n] * scale;
                        *(f32x4*)(yo + c) = o;
                        if (XB) { u32x2 w; w.x = cvt_pk_bf16(o[0], o[1]); w.y = cvt_pk_bf16(o[2], o[3]); *(u32x2*)(XB + (size_t)row * DM + c) = w; }
                        ss += (o[0] * o[0] + o[1] * o[1]) + (o[2] * o[2] + o[3] * o[3]);
                    }
                if (rowsq_out) { ss += __shfl_xor(ss, 16); ss += __shfl_xor(ss, 32); if (fq == 0) atomicAdd(rowsq_out + row, ss); }
            }
    }
};
struct EpiProj {
    static constexpr bool PERM = true, AFTER_DRAIN = false;
    const float* rowsq; unsigned char* ws; float* out; const float *gq, *gk, *bfg;
    __device__ __forceinline__ void operator()(const pg8::f32x4 (&acc)[2][2][4][2], const pg8::Unit& u, int wr, int wc, int fr, int fq) const {
        const int row0 = u.pm * 256 + wr * 64 + fr, pn = u.pn;
        if (pn < 6) {
            const int kind = pn >> 1, head = (pn & 1) * 4 + wc, colh = head * 64 + 8 * fq;
            f32x4 gg[2][2];
#pragma unroll
            for (int bj = 0; bj < 2; ++bj)
#pragma unroll
                for (int n = 0; n < 2; ++n) {
                    gg[bj][n] = (f32x4){1.f, 1.f, 1.f, 1.f};
                    if (kind == 0) gg[bj][n] = *(const f32x4*)(gq + 32 * bj + 8 * fq + 4 * n) * QSCALE;
                    if (kind == 1) gg[bj][n] = *(const f32x4*)(gk + 32 * bj + 8 * fq + 4 * n);
                }
#pragma unroll
            for (int ai = 0; ai < 2; ++ai)
#pragma unroll
                for (int m = 0; m < 4; ++m) {
                    const int row = row0 + ai * 128 + m * 16;
                    const float rs = rsqrtf(rowsq[row] * (1.f / 1024.f) + 1e-6f);
                    f32x4 v[2][2]; float ss = 0.f;
#pragma unroll
                    for (int bj = 0; bj < 2; ++bj)
#pragma unroll
                        for (int n = 0; n < 2; ++n) { v[bj][n] = acc[ai][bj][m][n] * rs; const f32x4 t = v[bj][n]; ss += (t[0] * t[0] + t[1] * t[1]) + (t[2] * t[2] + t[3] * t[3]); }
                    if (kind < 2) {
                        ss += __shfl_xor(ss, 16); ss += __shfl_xor(ss, 32);
                        const float nrm = rsqrtf(ss * (1.f / 64.f) + 1e-6f);
#pragma unroll
                        for (int bj = 0; bj < 2; ++bj)
#pragma unroll
                            for (int n = 0; n < 2; ++n) v[bj][n] = v[bj][n] * nrm * gg[bj][n];
                    }
                    bf16_t* dstb = (bf16_t*)(ws + WS_Q + (size_t)kind * (WS_K - WS_Q)) + (size_t)row * 512 + colh;
#pragma unroll
                    for (int bj = 0; bj < 2; ++bj) {
                        u32x4 w; w.x = cvt_pk_bf16(v[bj][0][0], v[bj][0][1]); w.y = cvt_pk_bf16(v[bj][0][2], v[bj][0][3]); w.z = cvt_pk_bf16(v[bj][1][0], v[bj][1][1]); w.w = cvt_pk_bf16(v[bj][1][2], v[bj][1][3]);
                        *(u32x4*)(dstb + 32 * bj) = w;
                    }
                    if (kind >= 1) {
                        float* dstf = (row < TP ? out + OFF_KP + (size_t)(kind - 1) * (OFF_VP - OFF_KP) + (size_t)row * 512 : out + OFF_KS + (size_t)(kind - 1) * (OFF_VS - OFF_KS) + (size_t)(row - TP) * 512) + colh;
#pragma unroll
                        for (int bj = 0; bj < 2; ++bj) { *(f32x4*)(dstf + 32 * bj) = v[bj][0]; *(f32x4*)(dstf + 32 * bj + 4) = v[bj][1]; }
                    }
                }
        } else if (pn < 13) {
            const int colr = (pn - 6) * 256 + 64 * wc + 8 * fq;
#pragma unroll
            for (int ai = 0; ai < 2; ++ai)
#pragma unroll
                for (int m = 0; m < 4; ++m) {
                    const int row = row0 + ai * 128 + m * 16;
                    const float rs = rsqrtf(rowsq[row] * (1.f / 1024.f) + 1e-6f);
                    const bool last = (row == TP - 1) || (row >= TP && ((row - TP) & 15) == 15);
                    float* dstf = (row < TP ? out + OFF_SHP : out + OFF_SHS + (size_t)((row - TP) >> 4) * RWP) + colr;
#pragma unroll
                    for (int bj = 0; bj < 2; ++bj) {
                        const f32x4 v0 = acc[ai][bj][m][0] * rs, v1 = acc[ai][bj][m][1] * rs;
                        u32x4 w; w.x = cvt_pk_bf16(v0[0], v0[1]); w.y = cvt_pk_bf16(v0[2], v0[3]); w.z = cvt_pk_bf16(v1[0], v1[1]); w.w = cvt_pk_bf16(v1[2], v1[3]);
                        *(u32x4*)((bf16_t*)(ws + WS_PRW) + (size_t)row * RWP + colr + 32 * bj) = w;
                        if (last) { *(f32x4*)(dstf + 32 * bj) = v0; *(f32x4*)(dstf + 32 * bj + 4) = v1; }
                    }
                }
        } else {
            if (wc == 0 && fq == 0) {
                const f32x4 b0 = *(const f32x4*)(bfg), b1 = *(const f32x4*)(bfg + 4);
#pragma unroll
                for (int ai = 0; ai < 2; ++ai)
#pragma unroll
                    for (int m = 0; m < 4; ++m) {
                        const int row = row0 + ai * 128 + m * 16;
                        const float rs = rsqrtf(rowsq[row] * (1.f / 1024.f) + 1e-6f);
                        const f32x4 z0 = acc[ai][0][m][0] * rs + b0, z1 = acc[ai][0][m][1] * rs + b1;
                        f32x4 l0, l1;
#pragma unroll
                        for (int j = 0; j < 4; ++j) { l0[j] = fminf(z0[j], 0.f) - __logf(1.f + __expf(-fabsf(z0[j]))); l1[j] = fminf(z1[j], 0.f) - __logf(1.f + __expf(-fabsf(z1[j]))); }
                        float* LOGF = (float*)(ws + WS_LOGF); *(f32x4*)(LOGF + (size_t)row * 8) = l0; *(f32x4*)(LOGF + (size_t)row * 8 + 4) = l1;
                        float* dstf = row < TP ? out + OFF_LFP + (size_t)row * 8 : out + OFF_LFS + (size_t)(row - TP) * 8;
                        *(f32x4*)dstf = l0; *(f32x4*)(dstf + 4) = l1;
                    }
            }
        }
    }
};
struct EpiBf16N {
    static constexpr bool PERM = true, AFTER_DRAIN = false;
    bf16_t* O; int ldc;
    __device__ __forceinline__ void operator()(const pg8::f32x4 (&acc)[2][2][4][2], const pg8::Unit& u, int wr, int wc, int fr, int fq) const {
        const int row0 = u.pm * 256 + wr * 64 + fr, col0 = u.pn * 256 + wc * 32 + 8 * fq;
#pragma unroll
        for (int ai = 0; ai < 2; ++ai)
#pragma unroll
            for (int m = 0; m < 4; ++m) {
                bf16_t* rowp = O + (size_t)(row0 + ai * 128 + m * 16) * ldc + col0;
#pragma unroll
                for (int bj = 0; bj < 2; ++bj) {
                    const f32x4 v0 = acc[ai][bj][m][0], v1 = acc[ai][bj][m][1];
                    u32x4 w; w.x = cvt_pk_bf16(v0[0], v0[1]); w.y = cvt_pk_bf16(v0[2], v0[3]); w.z = cvt_pk_bf16(v1[0], v1[1]); w.w = cvt_pk_bf16(v1[2], v1[3]);
                    *(u32x4*)(rowp + bj * 128) = w;
                }
            }
    }
};

__device__ __forceinline__ void phase4(CArgsP a, int wave, int lane) {
    unsigned char* ws = a->ws;
    const bf16_t* PRW = (const bf16_t*)(ws + WS_PRW); bf16_t* LA = (bf16_t*)(ws + WS_LORAA);
    const int gw = blockIdx.x * 8 + wave, NGW = gridDim.x * 8;
    const f32x4 mu = *(const f32x4*)(a->in[16] + 1536 + 4 * lane);
#pragma unroll 8
    for (int m = gw; m < MROWS; m += NGW) {
        const u32x2 pw = *(const u32x2*)(PRW + (size_t)m * RWP + 1536 + 4 * lane);
        f32x4 p = {bf2f(pw.x & 0xffffu), bf2f(pw.x >> 16), bf2f(pw.y & 0xffffu), bf2f(pw.y >> 16)};
        f32x4 q = {0.f, 0.f, 0.f, 0.f};
        const bool first = (m == 0) || (m >= TP && ((m - TP) & 15) == 0);
        if (!first) { const u32x2 qw = *(const u32x2*)(PRW + (size_t)(m - 1) * RWP + 1536 + 4 * lane); q = (f32x4){bf2f(qw.x & 0xffffu), bf2f(qw.x >> 16), bf2f(qw.y & 0xffffu), bf2f(qw.y >> 16)}; }
        else if (m >= TP) q = *(const f32x4*)(a->in[6] + (size_t)((m - TP) >> 4) * RWP + 1536 + 4 * lane);
        const f32x4 xs = p + (q - p) * mu;
        float o[4];
#pragma unroll
        for (int j = 0; j < 4; ++j) { const float e = __expf(lane < 16 ? 2.f * xs[j] : -xs[j]); const float rc = __builtin_amdgcn_rcpf(1.f + e); o[j] = lane < 16 ? 1.f - 2.f * rc : (lane < 32 ? xs[j] : rc); }
        u32x2 w; w.x = pk2(o[0], o[1]); w.y = pk2(o[2], o[3]);
        *(u32x2*)(LA + (size_t)m * KLORA + 4 * lane) = w;
    }
    if (blockIdx.x < 64) {
        const float* LOGF = (const float*)(ws + WS_LOGF); float* CUM = (float*)(ws + WS_CUM); float* TT = (float*)(ws + WS_TT);
        const int tile = blockIdx.x, h = wave, t0 = tile * 256 + 4 * lane;
        float v0 = LOGF[(size_t)(t0 + 0) * 8 + h], v1 = LOGF[(size_t)(t0 + 1) * 8 + h], v2 = LOGF[(size_t)(t0 + 2) * 8 + h], v3 = LOGF[(size_t)(t0 + 3) * 8 + h];
        v1 += v0; v2 += v1; v3 += v2;
        float inc = v3;
#pragma unroll
        for (int o = 1; o < 64; o <<= 1) { const float t = __shfl_up(inc, o); if (lane >= o) inc += t; }
        const float excl = inc - v3;
        CUM[(size_t)(t0 + 0) * 8 + h] = excl + v0; CUM[(size_t)(t0 + 1) * 8 + h] = excl + v1; CUM[(size_t)(t0 + 2) * 8 + h] = excl + v2; CUM[(size_t)(t0 + 3) * 8 + h] = excl + v3;
        if (lane == 63) TT[tile * 8 + h] = inc;
    }
}
__device__ __forceinline__ void cum_fixup(CArgsP a) {
    if (blockIdx.x < 64) {
        float* CUM = (float*)(a->ws + WS_CUM); const float* TT = (const float*)(a->ws + WS_TT);
        const int tile = blockIdx.x, h = threadIdx.x & 7;
        float pre = 0.f;
        for (int t = 0; t < tile; ++t) pre += TT[t * 8 + h];
#pragma unroll
        for (int i = 0; i < 4; ++i) { const int idx = threadIdx.x + 512 * i; CUM[(size_t)tile * 2048 + idx] += pre; }
    }
}

constexpr int AT_KVBUF = 17664, AT_VT = 8192, AT_CK = 17408, AT_MISC = 2 * AT_KVBUF, AT_VS = 144;
__device__ __forceinline__ int slotpos(int kv) { const int w = kv & 15; return (kv & ~15) + 8 * ((w >> 2) & 1) + (w & 3) + ((w >> 3) << 2); }
__device__ __forceinline__ void attn_unit(LAS unsigned char* lds, CArgsP a, int h, int qb, float thr) {
    const int tid = threadIdx.x, lane = tid & 63, wid = tid >> 6, r32 = lane & 31, hi = lane >> 5;
    const bf16_t* QB = (const bf16_t*)(a->ws + WS_Q); const bf16_t* KB = (const bf16_t*)(a->ws + WS_K); const bf16_t* VB = (const bf16_t*)(a->ws + WS_V);
    const float* CUM = (const float*)(a->ws + WS_CUM); bf16_t* MIX = (bf16_t*)(a->ws + WS_XB);
    const int q0 = qb * 256, qrow = q0 + wid * 32 + r32;
    bf16x8 qr[4];
#pragma unroll
    for (int d0 = 0; d0 < 4; ++d0) qr[d0] = *(const bf16x8*)(QB + (size_t)qrow * 512 + h * 64 + d0 * 16 + hi * 8);
    const float cref = CUM[(size_t)q0 * 8 + h];
    const int jt_hi = 4 * qb + 3;
    LAS int* s_lo = (LAS int*)(lds + AT_MISC);
    __syncthreads();
    if (tid == 0) *s_lo = 4 * qb;
    __syncthreads();
    {
        const float cq0 = cref;
        if (tid < 4 * qb) { const float cj = CUM[(size_t)(64 * tid + 63) * 8 + h]; if (cq0 - cj >= -thr) atomicMin((int*)s_lo, tid); }
    }
    __syncthreads();
    const int jt_lo = *s_lo;
    const int kvl = tid & 63, ch = tid >> 6;
    u32x4 kreg, vreg; float ckreg = 0.f;
    auto gload = [&](int jt) {
        const size_t off = (size_t)(64 * jt + kvl) * 512 + h * 64 + ch * 8;
        kreg = *(const u32x4*)(KB + off); vreg = *(const u32x4*)(VB + off);
        if (tid < 64) ckreg = (CUM[(size_t)(64 * jt + tid) * 8 + h] - cref) * LOG2E;
    };
    u32x4 kreg2, vreg2; float ckreg2 = 0.f;
    auto gload2 = [&](int jt) {
        const size_t off = (size_t)(64 * jt + kvl) * 512 + h * 64 + ch * 8;
        kreg2 = *(const u32x4*)(KB + off); vreg2 = *(const u32x4*)(VB + off);
        if (tid < 64) ckreg2 = (CUM[(size_t)(64 * jt + tid) * 8 + h] - cref) * LOG2E;
    };
    const int sp2 = 2 * slotpos(kvl);
    auto lstore = [&](int b) {
        LAS unsigned char* buf = lds + b * AT_KVBUF;
        *(LAS u32x4*)(buf + ch * 1024 + kvl * 16) = kreg;
        LAS unsigned char* vt = buf + AT_VT + (8 * ch) * AT_VS + sp2;
        *(LAS unsigned short*)(vt + 0 * AT_VS) = (unsigned short)(vreg.x & 0xffffu); *(LAS unsigned short*)(vt + 1 * AT_VS) = (unsigned short)(vreg.x >> 16);
        *(LAS unsigned short*)(vt + 2 * AT_VS) = (unsigned short)(vreg.y & 0xffffu); *(LAS unsigned short*)(vt + 3 * AT_VS) = (unsigned short)(vreg.y >> 16);
        *(LAS unsigned short*)(vt + 4 * AT_VS) = (unsigned short)(vreg.z & 0xffffu); *(LAS unsigned short*)(vt + 5 * AT_VS) = (unsigned short)(vreg.z >> 16);
        *(LAS unsigned short*)(vt + 6 * AT_VS) = (unsigned short)(vreg.w & 0xffffu); *(LAS unsigned short*)(vt + 7 * AT_VS) = (unsigned short)(vreg.w >> 16);
        if (tid < 64) *(LAS float*)(buf + AT_CK + 4 * tid) = ckreg;
    };
    gload(jt_hi); lstore(0);
    if (jt_lo < jt_hi) gload(jt_hi - 1);
    __syncthreads();
    float m_run = -INFINITY, l_run = 0.f;
    f32x16 o0 = {}, o1 = {};
    for (int jt = jt_hi; jt >= jt_lo; --jt) {
        const int b = (jt_hi - jt) & 1;
        if (jt - 2 >= jt_lo) gload2(jt - 2);
        LAS unsigned char* buf = lds + b * AT_KVBUF;
        if (64 * (jt - 4 * qb) <= 32 * wid + 31) {
        f32x16 p0 = {}, p1 = {};
#pragma unroll
        for (int d0 = 0; d0 < 4; ++d0) {
            const bf16x8 a0 = *(const LAS bf16x8*)(buf + (2 * d0 + hi) * 1024 + r32 * 16);
            const bf16x8 a1 = *(const LAS bf16x8*)(buf + (2 * d0 + hi) * 1024 + (32 + r32) * 16);
            p0 = __builtin_amdgcn_mfma_f32_32x32x16_bf16(a0, qr[d0], p0, 0, 0, 0);
            p1 = __builtin_amdgcn_mfma_f32_32x32x16_bf16(a1, qr[d0], p1, 0, 0, 0);
        }
        const int kvb = 64 * jt;
        float mx = -INFINITY;
        if (jt < 4 * qb) {
#pragma unroll
            for (int g = 0; g < 4; ++g) {
                const f32x4 c0 = *(const LAS f32x4*)(buf + AT_CK + 4 * (8 * g + 4 * hi));
                const f32x4 c1 = *(const LAS f32x4*)(buf + AT_CK + 4 * (32 + 8 * g + 4 * hi));
#pragma unroll
                for (int j = 0; j < 4; ++j) { const float s0 = p0[4 * g + j] - c0[j], s1 = p1[4 * g + j] - c1[j]; p0[4 * g + j] = s0; p1[4 * g + j] = s1; mx = fmaxf(mx, fmaxf(s0, s1)); }
            }
        } else {
#pragma unroll
            for (int g = 0; g < 4; ++g) {
                const f32x4 c0 = *(const LAS f32x4*)(buf + AT_CK + 4 * (8 * g + 4 * hi));
                const f32x4 c1 = *(const LAS f32x4*)(buf + AT_CK + 4 * (32 + 8 * g + 4 * hi));
#pragma unroll
                for (int j = 0; j < 4; ++j) {
                    const int kv = kvb + 8 * g + 4 * hi + j;
                    float s0 = p0[4 * g + j] - c0[j]; if (kv > qrow) s0 = -INFINITY;
                    float s1 = p1[4 * g + j] - c1[j]; if (kv + 32 > qrow) s1 = -INFINITY;
                    p0[4 * g + j] = s0; p1[4 * g + j] = s1; mx = fmaxf(mx, fmaxf(s0, s1));
                }
            }
        }
        mx = fmaxf(mx, __shfl_xor(mx, 32));
        float ps = 0.f;
        if (__any(mx > m_run)) {
            const float m_new = fmaxf(m_run, mx);
            const float alpha = __builtin_amdgcn_exp2f(m_run - m_new);
            m_run = m_new;
            l_run *= alpha;
#pragma unroll
            for (int r = 0; r < 16; ++r) { o0[r] *= alpha; o1[r] *= alpha; }
        }
#pragma unroll
        for (int r = 0; r < 16; ++r) { p0[r] = __builtin_amdgcn_exp2f(p0[r] - m_run); p1[r] = __builtin_amdgcn_exp2f(p1[r] - m_run); ps += p0[r] + p1[r]; }
        l_run += ps;
        bf16x8 pf[4];
#pragma unroll
        for (int bb = 0; bb < 2; ++bb) {
            u32x4 w0, w1;
            w0.x = cvt_pk_bf16(p0[8 * bb + 0], p0[8 * bb + 1]); w0.y = cvt_pk_bf16(p0[8 * bb + 2], p0[8 * bb + 3]); w0.z = cvt_pk_bf16(p0[8 * bb + 4], p0[8 * bb + 5]); w0.w = cvt_pk_bf16(p0[8 * bb + 6], p0[8 * bb + 7]);
            w1.x = cvt_pk_bf16(p1[8 * bb + 0], p1[8 * bb + 1]); w1.y = cvt_pk_bf16(p1[8 * bb + 2], p1[8 * bb + 3]); w1.z = cvt_pk_bf16(p1[8 * bb + 4], p1[8 * bb + 5]); w1.w = cvt_pk_bf16(p1[8 * bb + 6], p1[8 * bb + 7]);
            pf[bb] = __builtin_bit_cast(bf16x8, w0); pf[2 + bb] = __builtin_bit_cast(bf16x8, w1);
        }
#pragma unroll
        for (int kb = 0; kb < 4; ++kb) {
            const bf16x8 v0 = *(const LAS bf16x8*)(buf + AT_VT + (r32) * AT_VS + (16 * kb + 8 * hi) * 2);
            const bf16x8 v1 = *(const LAS bf16x8*)(buf + AT_VT + (32 + r32) * AT_VS + (16 * kb + 8 * hi) * 2);
            o0 = __builtin_amdgcn_mfma_f32_32x32x16_bf16(v0, pf[kb], o0, 0, 0, 0);
            o1 = __builtin_amdgcn_mfma_f32_32x32x16_bf16(v1, pf[kb], o1, 0, 0, 0);
        }
        }
        if (jt > jt_lo) lstore(b ^ 1);
        asm volatile("s_waitcnt lgkmcnt(0)\n\ts_barrier" ::: "memory");
        kreg = kreg2; vreg = vreg2; ckreg = ckreg2;
    }
    const float lt = l_run + __shfl_xor(l_run, 32);
    const float inv = 1.f / lt;
    bf16_t* orow = MIX + (size_t)qrow * DM + h * 64 + 4 * hi;
#pragma unroll
    for (int g = 0; g < 4; ++g) {
        u32x2 w0, w1;
        w0.x = cvt_pk_bf16(o0[4 * g] * inv, o0[4 * g + 1] * inv); w0.y = cvt_pk_bf16(o0[4 * g + 2] * inv, o0[4 * g + 3] * inv);
        w1.x = cvt_pk_bf16(o1[4 * g] * inv, o1[4 * g + 1] * inv); w1.y = cvt_pk_bf16(o1[4 * g + 2] * inv, o1[4 * g + 3] * inv);
        *(u32x2*)(orow + 8 * g) = w0; *(u32x2*)(orow + 32 + 8 * g) = w1;
    }
}

constexpr int SA_C = 0, SA_Q = 4352, SA_SC = 8448, SA_NK = PAST + TSS;
__device__ __forceinline__ void attn_sample_unit(LAS unsigned char* lds, CArgsP a, int b, int h) {
    const int tid = threadIdx.x, lane = tid & 63, wid = tid >> 6;
    LAS float* C = (LAS float*)(lds + SA_C); LAS float* Qs = (LAS float*)(lds + SA_Q); LAS float* SC = (LAS float*)(lds + SA_SC);
    const float* LOGF = (const float*)(a->ws + WS_LOGF); const bf16_t* QB = (const bf16_t*)(a->ws + WS_Q); bf16_t* MIX = (bf16_t*)(a->ws + WS_XB);
    const float* ck = a->in[2]; const float* cv = a->in[3]; const float* clf = a->in[4];
    const float* nk = a->out + OFF_KS; const float* nv = a->out + OFF_VS;
    __syncthreads();
    if (wid == 0) {
        float v[17]; float run = 0.f;
#pragma unroll
        for (int i = 0; i < 17; ++i) {
            const int j = 17 * lane + i; float x = 0.f;
            if (j < PAST) x = clf[((size_t)b * PAST + j) * 8 + h]; else if (j < SA_NK) x = LOGF[(size_t)(TP + 16 * b + (j - PAST)) * 8 + h];
            run += x; v[i] = run;
        }
        float inc = run;
#pragma unroll
        for (int o = 1; o < 64; o <<= 1) { const float t = __shfl_up(inc, o); if (lane >= o) inc += t; }
        const float excl = inc - run;
#pragma unroll
        for (int i = 0; i < 17; ++i) { const int j = 17 * lane + i; if (j < SA_NK) C[j] = excl + v[i]; }
    } else {
        for (int i = tid - 64; i < 1024; i += 448) { const int t = i >> 6, d = i & 63; Qs[i] = bf2f(QB[(size_t)(TP + 16 * b + t) * 512 + h * 64 + d]); }
    }
    __syncthreads();
    for (int j = tid; j < SA_NK; j += 512) {
        const float* kp = j < PAST ? ck + (((size_t)b * PAST + j) * 8 + h) * 64 : nk + (size_t)(16 * b + (j - PAST)) * 512 + h * 64;
        float acc[16];
#pragma unroll
        for (int t = 0; t < 16; ++t) acc[t] = 0.f;
#pragma unroll
        for (int hb = 0; hb < 2; ++hb) {
            f32x4 kr[8];
#pragma unroll
            for (int i = 0; i < 8; ++i) kr[i] = *(const f32x4*)(kp + 32 * hb + 4 * i);
#pragma unroll
            for (int i = 0; i < 8; ++i) {
                asm volatile("" ::: "memory");
                const f32x4 k4 = kr[i];
#pragma unroll
                for (int t = 0; t < 16; ++t) { const f32x4 q4 = *(const LAS f32x4*)(Qs + t * 64 + 32 * hb + 4 * i); acc[t] += (q4[0] * k4[0] + q4[1] * k4[1]) + (q4[2] * k4[2] + q4[3] * k4[3]); }
            }
        }
        const float cj = C[j];
#pragma unroll
        for (int t = 0; t < 16; ++t) SC[t * SA_NK + j] = acc[t] + (C[PAST + t] - cj) * LOG2E;
    }
    __syncthreads();
#pragma unroll
    for (int tt = 0; tt < 2; ++tt) {
        const int t = 2 * wid + tt; LAS float* row = SC + t * SA_NK;
        float mx = -INFINITY;
        for (int j = lane; j < SA_NK; j += 64) { if (j > PAST + t) row[j] = -INFINITY; mx = fmaxf(mx, row[j]); }
        mx = wave_max(mx);
        float sum = 0.f;
        for (int j = lane; j < SA_NK; j += 64) { const float p = __builtin_amdgcn_exp2f(row[j] - mx); row[j] = p; sum += p; }
        sum = wave_sum(sum);
        const float inv = 1.f / sum;
        for (int j = lane; j < SA_NK; j += 64) row[j] *= inv;
    }
    __syncthreads();
    {
        float acc[16];
#pragma unroll
        for (int t = 0; t < 16; ++t) acc[t] = 0.f;
        const float* vp = cv + ((size_t)b * PAST * 8 + h) * 64 + lane;
        float vv[8], vn8[8];
#pragma unroll
        for (int i = 0; i < 8; ++i) vv[i] = vp[(size_t)(wid + 8 * i) * 512];
#pragma unroll 1
        for (int j0 = wid; j0 < PAST; j0 += 64) {
            const int jn = (j0 + 64 < PAST) ? j0 + 64 : j0;
#pragma unroll
            for (int i = 0; i < 8; ++i) vn8[i] = vp[(size_t)(jn + 8 * i) * 512];
#pragma unroll
            for (int i = 0; i < 8; ++i) {
                asm volatile("" ::: "memory");
#pragma unroll
                for (int t = 0; t < 16; ++t) acc[t] += SC[t * SA_NK + j0 + 8 * i] * vv[i];
            }
#pragma unroll
            for (int i = 0; i < 8; ++i) vv[i] = vn8[i];
        }
        {
            const float* vn = nv + (size_t)(16 * b) * 512 + h * 64 + lane;
            const float v0 = vn[(size_t)wid * 512], v1 = vn[(size_t)(wid + 8) * 512];
#pragma unroll
            for (int t = 0; t < 16; ++t) acc[t] += SC[t * SA_NK + PAST + wid] * v0 + SC[t * SA_NK + PAST + wid + 8] * v1;
        }
        __syncthreads();
        LAS float* red = SC;
#pragma unroll
        for (int t = 0; t < 16; ++t) red[(wid * 16 + t) * 64 + lane] = acc[t];
        __syncthreads();
        {
            const int t = tid >> 5, d = 2 * (tid & 31);
            float a0 = 0.f, a1 = 0.f;
#pragma unroll
            for (int w = 0; w < 8; ++w) { a0 += red[(w * 16 + t) * 64 + d]; a1 += red[(w * 16 + t) * 64 + d + 1]; }
            *(unsigned*)(MIX + (size_t)(TP + 16 * b + t) * DM + h * 64 + d) = pk2(a0, a1);
        }
    }
}

constexpr int NSEG = 64, SEGCH = TP / 16 / NSEG;
constexpr size_t WS_PM = WS_SEG, WS_UM = WS_W1I, WS_SS = WS_LORAA;
constexpr int SC_CHB = 7 * 16 * 64 * 4, SC_Y = 2 * SC_CHB, SC_HALF = SC_Y + 16 * 64 * 4;
static_assert(2 * SC_HALF <= 131072, "scan LDS");
__device__ __forceinline__ float wave_sum_fast(float x) {
    x += dpp_f<0xB1>(x); x += dpp_f<0x4E>(x); x += dpp_f<0x141>(x); x += dpp_f<0x140>(x);
    x += __builtin_bit_cast(float, __builtin_amdgcn_update_dpp(0, __builtin_bit_cast(int, x), 0x142, 0xa, 0xf, false));
    x += __builtin_bit_cast(float, __builtin_amdgcn_update_dpp(0, __builtin_bit_cast(int, x), 0x143, 0xc, 0xf, false));
    return __builtin_bit_cast(float, __builtin_amdgcn_readlane(__builtin_bit_cast(int, x), 63));
}
struct ScanRaw { unsigned prk[4], pvq[4], qkv[4], lwa[4]; unsigned short lg[4]; };
struct ScanUnit { int seq, h, c0; const float* S0; float* Sout; float* Pout; };
typedef float f32x2 __attribute__((ext_vector_type(2)));
struct V8 { f32x2 p[4]; };
__device__ __forceinline__ V8 ld8(const LAS float* p) {
    const f32x4 a = *(const LAS f32x4*)p, b = *(const LAS f32x4*)(p + 4);
    V8 r; r.p[0] = __builtin_shufflevector(a, a, 0, 1); r.p[1] = __builtin_shufflevector(a, a, 2, 3); r.p[2] = __builtin_shufflevector(b, b, 0, 1); r.p[3] = __builtin_shufflevector(b, b, 2, 3); return r;
}
__device__ __forceinline__ float dot8(const V8& S, const V8& k) { f32x2 acc = S.p[0] * k.p[0]; acc = S.p[1] * k.p[1] + acc; acc = S.p[2] * k.p[2] + acc; acc = S.p[3] * k.p[3] + acc; return acc.x + acc.y; }
__device__ __forceinline__ float red8(float d) { d += dpp_f<0xB1>(d); d += dpp_f<0x4E>(d); d += dpp_f<0x141>(d); return d; }
__device__ __forceinline__ void upd8(V8& S, const V8& w, const V8& b, const V8& k, float sa, float vv) {
    const f32x2 sa2 = {sa, sa}, vv2 = {vv, vv};
#pragma unroll
    for (int i = 0; i < 4; ++i) { f32x2 t = vv2 * k.p[i]; t = sa2 * b.p[i] + t; S.p[i] = S.p[i] * w.p[i] + t; }
}
__device__ __forceinline__ void updp8(V8& S, const V8& w, const V8& b, float sa) {
    const f32x2 sa2 = {sa, sa};
#pragma unroll
    for (int i = 0; i < 4; ++i) { const f32x2 t = sa2 * b.p[i]; S.p[i] = S.p[i] * w.p[i] + t; }
}
template <int MODE>
__device__ __forceinline__ void scan_pair(LAS unsigned char* lds, CArgsP a, const ScanUnit u, int nch) {
    const int tid = threadIdx.x, lane = tid & 63, wid = tid >> 6, half = wid >> 2, hw = wid & 3, ks = lane & 7, vr0 = hw * 16 + (lane >> 3), vr1 = vr0 + 8;
    LAS unsigned char* hl = lds + half * SC_HALF;
    const bf16_t* PRW = (const bf16_t*)(a->ws + WS_PRW); const bf16_t* LORA = (const bf16_t*)(a->ws + WS_LORA); bf16_t* MIX = (bf16_t*)(a->ws + WS_XB);
    const int seq = u.seq, h = u.h, c0 = u.c0;
    const int rowbase = seq == 0 ? 0 : TP + 16 * (seq - 1);
    const int c_ = h * 64 + lane;
    const float mu_r = a->in[16][c_], mu_k = a->in[16][512 + c_], mu_v = a->in[16][1024 + c_], w0c = a->in[17][c_], a0c = a->in[19][c_];
    const float kkc = a->in[22][c_], kac = a->in[23][c_], rkc = a->in[24][c_], lng = a->in[25][c_], lnb = a->in[26][c_];
    V8 Sa, Sb, Pa, Pb;
#pragma unroll
    for (int i = 0; i < 4; ++i) {
        Sa.p[i] = (f32x2){0.f, 0.f}; Sb.p[i] = (f32x2){0.f, 0.f};
        Pa.p[i] = (f32x2){(8 * ks + 2 * i == vr0) ? 1.f : 0.f, (8 * ks + 2 * i + 1 == vr0) ? 1.f : 0.f};
        Pb.p[i] = (f32x2){(8 * ks + 2 * i == vr1) ? 1.f : 0.f, (8 * ks + 2 * i + 1 == vr1) ? 1.f : 0.f};
    }
    if (u.S0) {
        const float* sp = u.S0 + (size_t)vr0 * 64 + 8 * ks;
        const f32x4 s0 = *(const f32x4*)sp, s1 = *(const f32x4*)(sp + 4), s2 = *(const f32x4*)(sp + 512), s3 = *(const f32x4*)(sp + 516);
        Sa.p[0] = (f32x2){s0[0], s0[1]}; Sa.p[1] = (f32x2){s0[2], s0[3]}; Sa.p[2] = (f32x2){s1[0], s1[1]}; Sa.p[3] = (f32x2){s1[2], s1[3]};
        Sb.p[0] = (f32x2){s2[0], s2[1]}; Sb.p[1] = (f32x2){s2[2], s2[3]}; Sb.p[2] = (f32x2){s3[0], s3[1]}; Sb.p[3] = (f32x2){s3[2], s3[3]};
    }
    __syncthreads();
    ScanRaw R;
    float sh0[3];
    auto rawload = [&](int c) {
#pragma unroll
        for (int tt = 0; tt < 4; ++tt) {
            const int tl = 16 * c + 4 * hw + tt; const size_t m = (size_t)rowbase + tl;
            const unsigned pr = PRW[m * RWP + c_], pk = PRW[m * RWP + 512 + c_], pv = PRW[m * RWP + 1024 + c_];
            unsigned qr = 0, qk = 0, qv = 0;
            if (tl > 0) { qr = PRW[(m - 1) * RWP + c_]; qk = PRW[(m - 1) * RWP + 512 + c_]; qv = PRW[(m - 1) * RWP + 1024 + c_]; }
            else {
                sh0[0] = 0.f; sh0[1] = 0.f; sh0[2] = 0.f;
                if (seq > 0) { const float* s0 = a->in[6] + (size_t)(seq - 1) * RWP; sh0[0] = s0[c_]; sh0[1] = s0[512 + c_]; sh0[2] = s0[1024 + c_]; }
            }
            const unsigned lw = LORA[m * NLORA + c_], la = LORA[m * NLORA + 512 + c_];
            R.prk[tt] = pr | (pk << 16); R.pvq[tt] = pv | (qr << 16); R.qkv[tt] = qk | (qv << 16); R.lwa[tt] = lw | (la << 16);
            R.lg[tt] = LORA[m * NLORA + 1024 + c_];
        }
    };
    auto prep = [&](int c, int b) {
        LAS float* cb = (LAS float*)(hl + b * SC_CHB);
#pragma unroll
        for (int tt = 0; tt < 4; ++tt) {
            const int t = 4 * hw + tt, tl = 16 * c + t;
            const float pr = bf2f(R.prk[tt] & 0xffffu), pk = bf2f(R.prk[tt] >> 16), pv = bf2f(R.pvq[tt] & 0xffffu);
            float qr = bf2f(R.pvq[tt] >> 16), qk = bf2f(R.qkv[tt] & 0xffffu), qv = bf2f(R.qkv[tt] >> 16);
            if (tl == 0) { qr = sh0[0]; qk = sh0[1]; qv = sh0[2]; }
            const float xr = pr + (qr - pr) * mu_r, xk = pk + (qk - pk) * mu_k, xv = pv + (qv - pv) * mu_v;
            const float wp = w0c + bf2f(R.lwa[tt] & 0xffffu);
            const float w = __expf(-0.6065306597126334f * __builtin_amdgcn_rcpf(1.f + __expf(-wp)));
            const float av = __builtin_amdgcn_rcpf(1.f + __expf(-(a0c + bf2f(R.lwa[tt] >> 16))));
            float kk = xk * kkc;
            const float n2 = wave_sum_fast(kk * kk);
            kk = kk * rsqrtf(fmaxf(n2, 1e-24f));
            const float kp = xk * (1.f + (av - 1.f) * kac);
            cb[(0 * 16 + t) * 64 + lane] = w; cb[(1 * 16 + t) * 64 + lane] = kk; cb[(2 * 16 + t) * 64 + lane] = kk * av; cb[(3 * 16 + t) * 64 + lane] = kp;
            cb[(4 * 16 + t) * 64 + lane] = xr; cb[(5 * 16 + t) * 64 + lane] = xv; cb[(6 * 16 + t) * 64 + lane] = bf2f(R.lg[tt]);
        }
    };
    rawload(c0); prep(c0, 0);
    __syncthreads();
    LAS float* Y = (LAS float*)(hl + SC_Y);
    for (int ci = 0; ci < nch; ++ci) {
        const int b = ci & 1, c = c0 + ci;
        if (ci + 1 < nch) rawload(c + 1);
        const LAS float* cb = (const LAS float*)(hl + b * SC_CHB);
#pragma unroll 8
        for (int t = 0; t < 16; ++t) {
            const LAS float* p = cb + t * 64 + 8 * ks;
            const V8 w = ld8(p), kk = ld8(p + 1024), bb = ld8(p + 2048), kv = ld8(p + 3072);
            const float va = cb[(5 * 16 + t) * 64 + vr0], vb = cb[(5 * 16 + t) * 64 + vr1];
            float da = dot8(Sa, kk), db = dot8(Sb, kk);
            da = red8(da); db = red8(db);
            upd8(Sa, w, bb, kv, -da, va); upd8(Sb, w, bb, kv, -db, vb);
            if (MODE == 1) {
                float pa = dot8(Pa, kk), pb = dot8(Pb, kk);
                pa = red8(pa); pb = red8(pb);
                updp8(Pa, w, bb, -pa); updp8(Pb, w, bb, -pb);
            } else {
                const V8 rr = ld8(p + 4096);
                float ya = dot8(Sa, rr), yb = dot8(Sb, rr);
                ya = red8(ya); yb = red8(yb);
                if (ks == 0) { Y[t * 64 + vr0] = ya; Y[t * 64 + vr1] = yb; }
            }
        }
        __syncthreads();
        if (MODE == 0) {
#pragma unroll
            for (int tt = 0; tt < 4; ++tt) {
                const int t = 4 * hw + tt; const size_t m = (size_t)rowbase + 16 * c + t;
                const float y = Y[t * 64 + lane];
                const float mean = wave_sum_fast(y) * (1.f / 64.f); const float dv = y - mean;
                const float var = wave_sum_fast(dv * dv) * (1.f / 64.f);
                const float yn = dv * rsqrtf(var + 64e-5f) * lng + lnb;
                const float r = cb[(4 * 16 + t) * 64 + lane], kp = cb[(3 * 16 + t) * 64 + lane], v = cb[(5 * 16 + t) * 64 + lane], g = cb[(6 * 16 + t) * 64 + lane];
                const float rk = wave_sum_fast(r * kp * rkc);
                MIX[m * DM + 512 + c_] = (bf16_t)f2bf((yn + rk * v) * g);
            }
        }
        if (ci + 1 < nch) prep(c + 1, b ^ 1);
        __syncthreads();
    }
    if (u.Sout) {
        float* so = u.Sout + (size_t)vr0 * 64 + 8 * ks;
        *(f32x4*)so = (f32x4){Sa.p[0].x, Sa.p[0].y, Sa.p[1].x, Sa.p[1].y}; *(f32x4*)(so + 4) = (f32x4){Sa.p[2].x, Sa.p[2].y, Sa.p[3].x, Sa.p[3].y};
        *(f32x4*)(so + 512) = (f32x4){Sb.p[0].x, Sb.p[0].y, Sb.p[1].x, Sb.p[1].y}; *(f32x4*)(so + 516) = (f32x4){Sb.p[2].x, Sb.p[2].y, Sb.p[3].x, Sb.p[3].y};
    }
    if (MODE == 1) {
        float* po = u.Pout + (size_t)vr0 * 64 + 8 * ks;
        *(f32x4*)po = (f32x4){Pa.p[0].x, Pa.p[0].y, Pa.p[1].x, Pa.p[1].y}; *(f32x4*)(po + 4) = (f32x4){Pa.p[2].x, Pa.p[2].y, Pa.p[3].x, Pa.p[3].y};
        *(f32x4*)(po + 512) = (f32x4){Pb.p[0].x, Pb.p[0].y, Pb.p[1].x, Pb.p[1].y}; *(f32x4*)(po + 516) = (f32x4){Pb.p[2].x, Pb.p[2].y, Pb.p[3].x, Pb.p[3].y};
    }
}
__device__ __forceinline__ void scan_combine(LAS unsigned char* lds, CArgsP a) {
    if (blockIdx.x >= 64) return;
    const int tid = threadIdx.x, h = blockIdx.x >> 3, rw = tid >> 6, v = (blockIdx.x & 7) * 8 + rw, kq = tid & 63;
    const float* PM = (const float*)(a->ws + WS_PM); const float* UM = (const float*)(a->ws + WS_UM); float* SS = (float*)(a->ws + WS_SS);
    LAS float* Sl = (LAS float*)lds;
    LAS float* Pl = (LAS float*)(lds + 4096);
    constexpr int GL = NSEG - 2;
    float cur = SS[((size_t)(1 * 8 + h) * 64 + v) * 64 + kq];
    f32x4 pa, pb;
    float u1, u2;
    {
        const f32x4* P1 = (const f32x4*)(PM + (size_t)(1 * 8 + h) * 4096);
        *(LAS f32x4*)(Pl + 1 * 4096 + 4 * tid) = P1[tid]; *(LAS f32x4*)(Pl + 1 * 4096 + 2048 + 4 * tid) = P1[512 + tid];
        if (GL >= 2) { const f32x4* P2 = (const f32x4*)(PM + (size_t)(2 * 8 + h) * 4096);
            *(LAS f32x4*)(Pl + 2 * 4096 + 4 * tid) = P2[tid]; *(LAS f32x4*)(Pl + 2 * 4096 + 2048 + 4 * tid) = P2[512 + tid]; }
        u1 = UM[((size_t)(1 * 8 + h) * 64 + v) * 64 + kq];
        u2 = GL >= 2 ? UM[((size_t)(2 * 8 + h) * 64 + v) * 64 + kq] : 0.f;
    }
    for (int g = 1; g <= GL; ++g) {
        const bool pf = (g + 2 <= GL);
        float u3 = 0.f;
        if (pf) { const f32x4* Pn = (const f32x4*)(PM + (size_t)((g + 2) * 8 + h) * 4096); pa = Pn[tid]; pb = Pn[512 + tid]; u3 = UM[((size_t)((g + 2) * 8 + h) * 64 + v) * 64 + kq]; }
        asm volatile("s_waitcnt lgkmcnt(0)\n\ts_barrier" ::: "memory");
        const LAS float* Pg = Pl + (g % 3) * 4096 + kq;
        float acc0 = u1, acc1 = 0.f, acc2 = 0.f, acc3 = 0.f;
        const int curi = __builtin_bit_cast(int, cur);
#pragma unroll
        for (int k = 0; k < 64; k += 4) {
            const float s0 = __builtin_bit_cast(float, __builtin_amdgcn_readlane(curi, k)), s1 = __builtin_bit_cast(float, __builtin_amdgcn_readlane(curi, k + 1));
            const float s2 = __builtin_bit_cast(float, __builtin_amdgcn_readlane(curi, k + 2)), s3 = __builtin_bit_cast(float, __builtin_amdgcn_readlane(curi, k + 3));
            acc0 += s0 * Pg[(k + 0) * 64]; acc1 += s1 * Pg[(k + 1) * 64]; acc2 += s2 * Pg[(k + 2) * 64]; acc3 += s3 * Pg[(k + 3) * 64];
        }
        cur = (acc0 + acc1) + (acc2 + acc3);
        SS[((size_t)((g + 1) * 8 + h) * 64 + v) * 64 + kq] = cur;
        if (pf) { LAS float* dst = Pl + ((g + 2) % 3) * 4096; *(LAS f32x4*)(dst + 4 * tid) = pa; *(LAS f32x4*)(dst + 2048 + 4 * tid) = pb; }
        u1 = u2; u2 = u3;
    }
}

constexpr size_t WS_BAR = 512 * 1024, BAR_BYTES = 16 * 1024;
constexpr int LDS_MISC = 131072 + 64;
#define XB_TMO      128
#define XB_XCNT(j)  (256  + 64 * (j))
#define XB_XSUB(j)  (1280 + 64 * (j))
#define XB_XGEN(j)  (2304 + 64 * (j))
#define XB_TOP      3328
#define XB_TOPGEN   3392
#define XCD_BAR_WORDS 3456
#define XB_SPIN_CAP (1u << 18)

__device__ __forceinline__ unsigned xb_ld(unsigned* p)              { return __hip_atomic_load(p, __ATOMIC_RELAXED, __HIP_MEMORY_SCOPE_AGENT); }
__device__ __forceinline__ unsigned xb_add(unsigned* p, unsigned v) { return __hip_atomic_fetch_add(p, v, __ATOMIC_RELAXED, __HIP_MEMORY_SCOPE_AGENT); }
__device__ __forceinline__ unsigned xb_xcc_id() { return (unsigned)__builtin_amdgcn_s_getreg((3 << 11) | 20) & 0xFu; }
#define XB_SPIN(cond, bar) do { unsigned _sp = 0; while (cond) { __builtin_amdgcn_s_sleep(1); \
    if ((++_sp & 255u) == 0u) { if (xb_ld(&(bar)[XB_TMO])) break; if (_sp > XB_SPIN_CAP) { atomicAdd(&(bar)[XB_TMO], 1u); break; } } } } while (0)

struct XcdBarrier {
    unsigned* bar; unsigned x;
    volatile LAS unsigned* st;
};

__device__ __forceinline__ XcdBarrier xcd_barrier_post(unsigned* bar, volatile LAS unsigned* st) {
    XcdBarrier b; b.bar = bar; b.x = xb_xcc_id(); b.st = st;
    if (threadIdx.x == 0) (void)xb_add(&bar[XB_XCNT(b.x)], 1u);
    return b;
}
__device__ __forceinline__ void xcd_barrier_complete(unsigned* bar, unsigned x, unsigned& nloc, unsigned& nx) {
    const unsigned G = gridDim.x * gridDim.y * gridDim.z;
    unsigned sum, cnt, mine, sp = 0u;
    for (;;) {
        sum = 0u; cnt = 0u; mine = 0u;
#pragma unroll
        for (unsigned j = 0; j < 16; ++j) { const unsigned c = xb_ld(&bar[XB_XCNT(j)]); sum += c; cnt += (c > 0u) ? 1u : 0u; mine = (j == x) ? c : mine; }
        if (sum == G) break;
        __builtin_amdgcn_s_sleep(1);
        if ((++sp & 255u) == 0u) { if (xb_ld(&bar[XB_TMO])) break; if (sp > XB_SPIN_CAP) { atomicAdd(&bar[XB_TMO], 1u); break; } }
    }
    nloc = mine > 0u ? mine : 1u; nx = cnt > 0u ? cnt : 1u;
}

__device__ __forceinline__ void xcd_barrier(const XcdBarrier& b) {
    asm volatile("s_waitcnt vmcnt(0)" ::: "memory");
    __syncthreads();
    if (threadIdx.x == 0) {
        unsigned* bar = b.bar;
        __builtin_amdgcn_s_waitcnt(0);
        unsigned nloc = b.st[0], nx = b.st[1];
        if (nloc == 0u) { xcd_barrier_complete(bar, b.x, nloc, nx); b.st[0] = nloc; b.st[1] = nx; }
        const unsigned old = xb_add(&bar[XB_XSUB(b.x)], 1u);
        const unsigned gen = old / nloc;
        if (old + 1u == (gen + 1u) * nloc) {
            __builtin_amdgcn_fence(__ATOMIC_RELEASE, "agent");
            asm volatile("s_waitcnt vmcnt(0)" ::: "memory");
            const unsigned og = xb_add(&bar[XB_TOP], 1u);
            const unsigned tg = og / nx;
            if (og + 1u == (tg + 1u) * nx) xb_add(&bar[XB_TOPGEN], 1u);
            else XB_SPIN(xb_ld(&bar[XB_TOPGEN]) == tg, bar);
            __builtin_amdgcn_fence(__ATOMIC_ACQUIRE, "agent");
            xb_add(&bar[XB_XGEN(b.x)], 1u);
            asm volatile("s_waitcnt vmcnt(0)" ::: "memory");
        } else {
            XB_SPIN(xb_ld(&bar[XB_XGEN(b.x)]) == gen, bar);
            __builtin_amdgcn_fence(__ATOMIC_ACQUIRE, "agent");
            asm volatile("s_waitcnt vmcnt(0)" ::: "memory");
        }
    }
    __syncthreads();
}

__device__ __forceinline__ void grid_bar(LAS unsigned char* lds) {
    CArgsP a = get_args(); XcdBarrier b; b.bar = (unsigned*)(a->ws + WS_BAR); b.x = xb_xcc_id(); b.st = (volatile LAS unsigned*)(lds + LDS_MISC);
    xcd_barrier(b);
}

constexpr int CNT_FFN1 = 3840, CNT_FFN2 = 3904;
struct SampleFirstOrder {
    int nM, nN, nwg, G, c, nS; unsigned* cnt;
    __device__ void init(int M, int N, int G_, int c_, unsigned* cnt_) { nM = M / 256; nN = N / 256; nwg = nM * nN; G = G_; c = c_; nS = nN; cnt = cnt_; }
    __device__ bool next(int i, pg8::Unit& u) const {
        long L = (long)i * G + c;
        if (G == 256 && nN == 22) {
            if (c >= G - 4) { if (i >= 3) return false; }
            else if (c >= G - 12 && i == 5) { const int k = c - (G - 12); L = (long)(3 + (k >> 2)) * G + (G - 4 + (k & 3)); }
        }
        if (L < nS) { u.pm = nM; u.pn = (int)L; return true; }
        L -= nS; if (L >= nwg) return false;
        int wgid = (int)L; { const int q = nwg / pg8::NXCD, r = nwg % pg8::NXCD, xcd = wgid % pg8::NXCD, off = wgid / pg8::NXCD; wgid = (xcd < r ? xcd * (q + 1) : r * (q + 1) + (xcd - r) * q) + off; }
        const int nig = pg8::WGM * nN, gid = wgid / nig, fm = gid * pg8::WGM, gsz = (nM - fm) < pg8::WGM ? (nM - fm) : pg8::WGM;
        u.pm = fm + ((wgid % nig) % gsz); u.pn = (wgid % nig) / gsz; return true;
    }
    __device__ __forceinline__ void a_ready(const pg8::Unit&) const {}
    __device__ __forceinline__ void done(const pg8::Unit& u) const {
        if (u.pm == nM) { __builtin_amdgcn_fence(__ATOMIC_RELEASE, "agent"); if ((threadIdx.x & 63) == 0) __hip_atomic_fetch_add(cnt, 1u, __ATOMIC_RELAXED, __HIP_MEMORY_SCOPE_AGENT); }
    }
};
struct OneUnit {
    int pm, pn;
    __device__ bool next(int i, pg8::Unit& u) const { if (i) return false; u.pm = pm; u.pn = pn; return true; }
    __device__ __forceinline__ void a_ready(const pg8::Unit&) const {}
    __device__ __forceinline__ void done(const pg8::Unit&) const {}
};
__device__ __forceinline__ void wait_count(unsigned* cnt, unsigned want) {
    if (threadIdx.x == 0) {
        unsigned sp = 0;
        while (__hip_atomic_load(cnt, __ATOMIC_RELAXED, __HIP_MEMORY_SCOPE_AGENT) < want && ++sp < (1u << 24)) __builtin_amdgcn_s_sleep(2);
        __builtin_amdgcn_fence(__ATOMIC_ACQUIRE, "agent");
        asm volatile("s_waitcnt vmcnt(0)" ::: "memory");
    }
    __syncthreads();
}

#ifdef PROBE_PHASE
__device__ __forceinline__ int probe_reps(int k) { int n = (k == PROBE_PHASE) ? 2 : 1; asm volatile("" : "+s"(n)); return n; }
#define PH(k) for (int r_ = 0, n_ = probe_reps(k); r_ < n_; ++r_)
#else
#define PH(k)
#endif
constexpr int LDS_BYTES = 136 * 1024;
__global__ void __launch_bounds__(512, 2) mega_fwd(Args a_unused) {
    extern __shared__ __attribute__((aligned(16))) unsigned char lds_raw[];
    cg::grid_group grid = cg::this_grid();
    LAS unsigned char* lds = (LAS unsigned char*)lds_raw;
    const int tid = threadIdx.x, lane = tid & 63, wave = __builtin_amdgcn_readfirstlane(tid >> 6);
    const int G = gridDim.x, bx = blockIdx.x;
    if (tid < 64) ((LAS unsigned*)(lds + 131072))[tid] = 0u;
    __syncthreads();

    { CArgsP a = get_args(); phase0(a, lds, wave, lane);
      if (bx == 0) { unsigned* bw = (unsigned*)(a->ws + WS_BAR); for (int i = tid; i < (int)(BAR_BYTES / 4); i += 512) bw[i] = 0u; } }
    grid.sync();
    { CArgsP a = get_args(); (void)xcd_barrier_post((unsigned*)(a->ws + WS_BAR), (volatile LAS unsigned*)(lds + LDS_MISC)); }
    PH(1) { CArgsP a = get_args(); unsigned char* ws = a->ws; unsigned* cnt = (unsigned*)(ws + WS_BAR) + CNT_FFN1;
      { pg8::Gemm g{(const bf16_t*)(ws + WS_XB), (const bf16_t*)(ws + WS_W1I), MROWS, 2 * DFF, DM}; SampleFirstOrder S; S.init(TP, 2 * DFF, G, bx, cnt);
        EpiSwiglu E{(bf16_t*)(ws + WS_H), (const float*)(ws + WS_ROWSQ0)}; pg8::gemm_phase<EpiSwiglu, SampleFirstOrder, true, true>(lds, g, S, E); }
      if (bx >= G - 4) {
        wait_count(cnt, 8u * (2 * DFF / 256));
        pg8::Gemm g{(const bf16_t*)(ws + WS_H), (const bf16_t*)(ws + WS_W1O), MROWS, DM, DFF}; OneUnit S{TP / 256, bx - (G - 4)};
        EpiResid E{a->in[0], a->in[1], a->out, (bf16_t*)(ws + WS_XB), (float*)(ws + WS_ROWSQ1), 0.5f, 0}; pg8::gemm_phase<EpiResid, OneUnit, true, true>(lds, g, S, E); } }
    grid_bar(lds);
    PH(2) { CArgsP a = get_args(); unsigned char* ws = a->ws;
      pg8::Gemm g{(const bf16_t*)(ws + WS_H), (const bf16_t*)(ws + WS_W1O), TP, DM, DFF}; pg8::StaticOrder S; S.init(TP, DM, G, bx);
      EpiResid E{a->in[0], a->in[1], a->out, (bf16_t*)(ws + WS_XB), (float*)(ws + WS_ROWSQ1), 0.5f, 0}; pg8::gemm_phase<EpiResid, pg8::StaticOrder, true, true>(lds, g, S, E); }
    grid_bar(lds);
    PH(3) { CArgsP a = get_args(); unsigned char* ws = a->ws;
      pg8::Gemm g{(const bf16_t*)(ws + WS_XB), (const bf16_t*)(ws + WS_WIN), MROWS, NPROJ, DM}; pg8::StaticOrder S; S.init(MROWS, NPROJ, G, bx);
      EpiProj E{(const float*)(ws + WS_ROWSQ1), ws, a->out, a->in[14], a->in[15], a->in[13]};
      pg8::gemm_phase<EpiProj, pg8::StaticOrder, true, true>(lds, g, S, E); }
    grid_bar(lds);
    PH(4) { CArgsP a = get_args(); phase4(a, wave, lane); }
    grid_bar(lds);
    { CArgsP a = get_args(); cum_fixup(a); }
    PH(5) { CArgsP a = get_args(); unsigned char* ws = a->ws;

      int kl = KLORA; asm volatile("" : "+s"(kl));
      pg8::Gemm g{(const bf16_t*)(ws + WS_LORAA), (const bf16_t*)(ws + WS_WLORA), MROWS, NLORA, kl}; pg8::StaticOrder S; S.init(MROWS, NLORA, G, bx);
      EpiBf16N E{(bf16_t*)(ws + WS_LORA), NLORA}; pg8::gemm_phase<EpiBf16N, pg8::StaticOrder, true, true>(lds, g, S, E);
      if (G == 256 && bx >= 134) convert_weights(a, lds, wave, lane, 1, bx - 134, 122); }
    grid_bar(lds);
    PH(6) {
        CArgsP a = get_args();
        float gqm = 0.f, gkm = 0.f;
        { const float gq = fabsf(a->in[14][lane]), gk = fabsf(a->in[15][lane]); gqm = wave_max(gq); gkm = wave_max(gk); }
        const float thr = 30.f + 16.f * gqm * gkm;
        float* SS = (float*)(a->ws + WS_SS); float* PM = (float*)(a->ws + WS_PM); float* UM = (float*)(a->ws + WS_UM);
        const int half = tid >> 8;
        constexpr int NUPP = 4 * (NSEG - 2), NSC = 4 + NUPP;
        PH(10) for (int it = bx; it < NSC; it += G) {
            if (it < 4) { const int hh = 2 * it + half; ScanUnit u{0, hh, 0, nullptr, SS + (size_t)(1 * 8 + hh) * 4096, nullptr}; scan_pair<0>(lds, a, u, SEGCH); }
            else { const int uu = 2 * (it - 4) + half, g = 1 + (uu >> 3), hh = uu & 7;
                ScanUnit u{0, hh, g * SEGCH, nullptr, UM + (size_t)(g * 8 + hh) * 4096, PM + (size_t)(g * 8 + hh) * 4096}; scan_pair<1>(lds, a, u, SEGCH); }
        }
        if (G == 256) {
            int a0, an;
            if (bx >= 252) { a0 = 500 + 3 * (bx - 252); an = 3; } else if (bx >= 4) { a0 = 2 * (bx - 4); an = 2; } else { a0 = 496 + bx; an = 1; }
            PH(11) for (int it = a0; it < a0 + an; ++it) attn_unit(lds, a, it & 7, 63 - (it >> 3), thr);
        } else {
            for (int it = (bx + G - NSC % G) % G; it < 512; it += G) attn_unit(lds, a, it & 7, 63 - (it >> 3), thr);
        }
        if (G != 256) for (int it = G - 1 - bx; it < 128; it += G) attn_sample_unit(lds, a, it >> 3, it & 7);
        if (G != 256) for (int it = ((G - 129 - bx) % G + G) % G; it < 64; it += G) {
            const int uu = 2 * it + half, sb = uu >> 3, hh = uu & 7;
            ScanUnit u{1 + sb, hh, 0, a->in[5] + (size_t)(sb * 8 + hh) * 4096, a->out + OFF_STS + (size_t)(sb * 8 + hh) * 4096, nullptr}; scan_pair<0>(lds, a, u, 1);
        }
    }
    grid_bar(lds);
    PH(7) { CArgsP a = get_args(); if (bx < 64 || G <= 64) scan_combine(lds, a); __syncthreads(); if (G != 256 && (bx >= 64 || G <= 64)) convert_weights(a, lds, wave, lane, 1, G <= 64 ? bx : bx - 64, G <= 64 ? G : G - 64); if (G == 256 && bx >= 64 && bx < 192) attn_sample_unit(lds, a, (bx - 64) >> 3, (bx - 64) & 7);
      if (G == 256 && bx >= 192) {
          const int uu = 2 * (bx - 192) + (tid >> 8), sb = uu >> 3, hh = uu & 7;
          ScanUnit u{1 + sb, hh, 0, a->in[5] + (size_t)(sb * 8 + hh) * 4096, a->out + OFF_STS + (size_t)(sb * 8 + hh) * 4096, nullptr}; scan_pair<0>(lds, a, u, 1);
      } }
    grid_bar(lds);
    PH(8) { CArgsP a = get_args();
      float* SS = (float*)(a->ws + WS_SS);
      const int half = tid >> 8;
      PH(14) for (int it = bx; it < 4 * (NSEG - 1); it += G) {
          const int uu = 2 * it + half, g = 1 + (uu >> 3), hh = uu & 7;
          ScanUnit u{0, hh, g * SEGCH, SS + (size_t)(g * 8 + hh) * 4096, g == NSEG - 1 ? a->out + OFF_STP + (size_t)hh * 4096 : nullptr, nullptr};
          scan_pair<0>(lds, a, u, SEGCH);
      }
      if (bx >= G - 4) {
        unsigned char* ws = a->ws;
        pg8::Gemm g{(const bf16_t*)(ws + WS_XB), (const bf16_t*)(ws + WS_WOUT), MROWS, DM, DM}; OneUnit S{TP / 256, bx - (G - 4)};
        EpiResid E{nullptr, nullptr, a->out, (bf16_t*)(ws + WS_X2B), (float*)(ws + WS_ROWSQ2), 1.0f, 1}; pg8::gemm_phase<EpiResid, OneUnit, true, true>(lds, g, S, E); }
    }
    grid_bar(lds);
    { CArgsP a = get_args(); unsigned char* ws = a->ws;
      pg8::Gemm g{(const bf16_t*)(ws + WS_XB), (const bf16_t*)(ws + WS_WOUT), TP, DM, DM}; pg8::StaticOrder S; S.init(TP, DM, G, bx);
      EpiResid E{nullptr, nullptr, a->out, (bf16_t*)(ws + WS_X2B), (float*)(ws + WS_ROWSQ2), 1.0f, 1}; pg8::gemm_phase<EpiResid, pg8::StaticOrder, true, true>(lds, g, S, E); }
    grid_bar(lds);
    PH(9) { CArgsP a = get_args(); unsigned char* ws = a->ws; unsigned* cnt = (unsigned*)(ws + WS_BAR) + CNT_FFN2;
      { pg8::Gemm g{(const bf16_t*)(ws + WS_X2B), (const bf16_t*)(ws + WS_W2I), MROWS, 2 * DFF, DM}; SampleFirstOrder S; S.init(TP, 2 * DFF, G, bx, cnt);
        EpiSwiglu E{(bf16_t*)(ws + WS_H), (const float*)(ws + WS_ROWSQ2)}; pg8::gemm_phase<EpiSwiglu, SampleFirstOrder, true, true>(lds, g, S, E); }
      if (bx >= G - 4) {
        wait_count(cnt, 8u * (2 * DFF / 256));
        pg8::Gemm g{(const bf16_t*)(ws + WS_H), (const bf16_t*)(ws + WS_W2O), MROWS, DM, DFF}; OneUnit S{TP / 256, bx - (G - 4)};
        EpiResid E{nullptr, nullptr, a->out, nullptr, nullptr, 0.5f, 1}; pg8::gemm_phase<EpiResid, OneUnit, true, true>(lds, g, S, E); } }
    grid_bar(lds);
    { CArgsP a = get_args(); unsigned char* ws = a->ws;
      pg8::Gemm g{(const bf16_t*)(ws + WS_H), (const bf16_t*)(ws + WS_W2O), TP, DM, DFF}; pg8::StaticOrder S; S.init(TP, DM, G, bx);
      EpiResid E{nullptr, nullptr, a->out, nullptr, nullptr, 0.5f, 1}; pg8::gemm_phase<EpiResid, pg8::StaticOrder, true, true>(lds, g, S, E); }
}

extern "C" void kernel_launch(void* const* d_in, const int* in_sizes, int n_in, void* d_out, int out_size, void* d_ws, size_t ws_size, hipStream_t stream) {
    static int grid = 0;
    if (grid == 0) {
        if (n_in != 30 || out_size != (int)OUT_TOTAL || ws_size < WS_END || in_sizes[0] != TP * DM) { fprintf(stderr, "kernel_launch: unexpected shapes (n_in %d out %d ws %zu)\n", n_in, out_size, ws_size); grid = -1; return; }
        int dev = 0, cus = 0, per_cu = 0;
        if (hipGetDevice(&dev) != hipSuccess || hipDeviceGetAttribute(&cus, hipDeviceAttributeMultiprocessorCount, dev) != hipSuccess) { grid = -1; return; }
        if (hipFuncSetAttribute((const void*)mega_fwd, hipFuncAttributeMaxDynamicSharedMemorySize, LDS_BYTES) != hipSuccess) { fprintf(stderr, "kernel_launch: hipFuncSetAttribute failed\n"); grid = -1; return; }
        if (hipOccupancyMaxActiveBlocksPerMultiprocessor(&per_cu, (const void*)mega_fwd, 512, LDS_BYTES) != hipSuccess || per_cu < 1) { fprintf(stderr, "kernel_launch: occupancy query failed (%d)\n", per_cu); (void)hipGetLastError(); grid = -1; return; }
        grid = cus * per_cu;
    }
    if (grid < 64) return;
    Args a{};
    for (int i = 0; i < 30; ++i) a.in[i] = (const float*)d_in[i];
    a.out = (float*)d_out; a.ws = (unsigned char*)d_ws;
    void* args[] = {&a};
    hipError_t e = hipLaunchCooperativeKernel((const void*)mega_fwd, dim3(grid), dim3(512), args, LDS_BYTES, stream);
    if (e != hipSuccess) fprintf(stderr, "kernel_launch: cooperative launch failed: %s (grid %d)\n", hipGetErrorString(e), grid);
}
```

```cpp
#include <hip/hip_runtime.h>
#include <hip/hip_cooperative_groups.h>
#include <cstdio>
#include <cstdint>
namespace cg = cooperative_groups;
namespace pg8 {
#define PG8_LAS __attribute__((address_space(3)))
typedef unsigned short bf16_t;
typedef short bf16x8 __attribute__((ext_vector_type(8)));
typedef float f32x4 __attribute__((ext_vector_type(4)));
typedef unsigned u32x4 __attribute__((ext_vector_type(4)));
constexpr int BM = 256, BK = 64, HALF = 128, HTB = HALF * BK * 2  , STAGE_BYTES = 8 * HTB, NXCD = 8, WGM = 8;

__host__ __device__ __forceinline__ int lds_byte(int r, int c) { const int st = (r >> 4) * 2 + (c >> 5), rr = r & 15, cc = c & 31, ob = rr * 64 + cc * 2; return st * 1024 + (ob ^ (((ob >> 9) & 1) << 5)); }
__host__ __device__ __forceinline__ void stage_rc(int b, int& R, int& C) { const int st = b / 1024, sb = b % 1024, swz = sb ^ (((sb >> 9) & 1) << 5); R = (st >> 1) * 16 + swz / 64; C = (st & 1) * 32 + (swz % 64) / 2; }
__host__ __device__ __forceinline__ int perm32(int rho) { const int n = rho >> 4, i = rho & 15; return 8 * (i >> 2) + 4 * n + (i & 3); }

struct Unit { int pm, pn; };
struct Gemm { const bf16_t* A; const bf16_t* Bt; int M, N, K; };

struct StaticOrder {
    int nM, nN, nwg, G, c;
    __host__ __device__ void init(int M, int N, int G_, int c_) { nM = M / BM; nN = N / BM; nwg = nM * nN; G = G_; c = c_; }
    __host__ __device__ bool next(int i, Unit& u) const {
        const long L = (long)i * G + c; if (L >= nwg) return false;
        int wgid = (int)L; { const int q = nwg / NXCD, r = nwg % NXCD, xcd = wgid % NXCD, off = wgid / NXCD; wgid = (xcd < r ? xcd * (q + 1) : r * (q + 1) + (xcd - r) * q) + off; }
        const int nig = WGM * nN, gid = wgid / nig, fm = gid * WGM, gsz = (nM - fm) < WGM ? (nM - fm) : WGM;
        u.pm = fm + ((wgid % nig) % gsz); u.pn = (wgid % nig) / gsz; return true;
    }
    __device__ __forceinline__ void a_ready(const Unit&) const {}
    __device__ __forceinline__ void done(const Unit&) const {}
};

__device__ __forceinline__ unsigned cvt_pk_bf16(float lo, float hi) { unsigned r; asm volatile("v_cvt_pk_bf16_f32 %0, %1, %2" : "=v"(r) : "v"(lo), "v"(hi)); return r; }
template <class Epi, class Sched, bool ALIGN_EPI = false, bool SP2 = false>
__device__ __forceinline__ void gemm_phase(PG8_LAS unsigned char* lds, const Gemm g, const Sched& S, const Epi& E) {
    int tid_l = threadIdx.x; asm volatile("" : "+v"(tid_l));
    const int tid = tid_l, wid = __builtin_amdgcn_readfirstlane(tid >> 6), lane = tid & 63, wr = wid >> 2, wc = wid & 3, fr = lane & 15, fq = lane >> 4;
    const int K = g.K, nt = K / BK;
    unsigned voffA[2], voffB[2];
#pragma unroll
    for (int i = 0; i < 2; ++i) { int R, C; stage_rc(tid * 16 + i * 8192, R, C); const int Rb = Epi::PERM ? ((R & ~31) + perm32(R & 31)) : R;
        voffA[i] = (unsigned)(R * K + C) * 2u; voffB[i] = (unsigned)(Rb * K + C) * 2u; }
    const size_t kstep = (size_t)(BK * 2);
    const size_t hstep = (size_t)HALF * K * 2;
    const size_t tstep = 2 * hstep;
    const unsigned ldsw = (unsigned)wid * 1024u;
    const int aoff = lds_byte(wr * 64 + fr, fq * 8), boff = lds_byte(wc * 32 + fr, fq * 8);
#define PG8_SA(b, h) (((b) * 2 + (h)) * HTB)
#define PG8_SB(b, h) ((4 + (b) * 2 + (h)) * HTB)
#define PG8_STAGE(bufoff, gbase, voff) do { _Pragma("unroll") for (int _i = 0; _i < 2; ++_i) \
        __builtin_amdgcn_global_load_lds((const unsigned*)((const char*)(gbase) + (voff)[_i]), (PG8_LAS unsigned*)(lds + (bufoff) + ldsw + _i * 8192), 16, 0, 0); } while (0)
#define PG8_LDA(dst, b, h) do { _Pragma("unroll") for (int m = 0; m < 4; ++m) _Pragma("unroll") for (int k = 0; k < 2; ++k) dst[m][k] = *(const PG8_LAS bf16x8*)(lds + PG8_SA(b, h) + aoff + m * 2048 + k * 1024); } while (0)
#define PG8_LDB(dst, b, h) do { _Pragma("unroll") for (int n = 0; n < 2; ++n) _Pragma("unroll") for (int k = 0; k < 2; ++k) dst[n][k] = *(const PG8_LAS bf16x8*)(lds + PG8_SB(b, h) + boff + n * 2048 + k * 1024); } while (0)
#define PG8_MMA(ai, bj, At, Bt) do { __builtin_amdgcn_s_setprio(1); _Pragma("unroll") for (int m = 0; m < 4; ++m) _Pragma("unroll") for (int n = 0; n < 2; ++n) _Pragma("unroll") for (int k = 0; k < 2; ++k) \
        acc[ai][bj][m][n] = __builtin_amdgcn_mfma_f32_16x16x32_bf16(Bt[n][k], At[m][k], acc[ai][bj][m][n], 0, 0, 0); __builtin_amdgcn_s_setprio(0); } while (0)
#define PG8_WAIT_V(n) asm volatile("s_waitcnt vmcnt(" #n ")" ::: "memory")
#define PG8_WAIT_L(n) asm volatile("s_waitcnt lgkmcnt(" #n ")" ::: "memory")
#define PG8_BAR __builtin_amdgcn_s_barrier()
#define PG8_SCHED __builtin_amdgcn_sched_barrier(0)
    Unit cur, nxt; int ui = 0;
    if (!S.next(0, cur)) return;
    f32x4 acc[2][2][4][2];
#pragma unroll
    for (int a = 0; a < 2; ++a)
#pragma unroll
        for (int b = 0; b < 2; ++b)
#pragma unroll
            for (int m = 0; m < 4; ++m)
#pragma unroll
                for (int n = 0; n < 2; ++n) acc[a][b][m][n] = (f32x4){0.f, 0.f, 0.f, 0.f};
    bf16x8 At[4][2], B0[2][2], B1[2][2];
    const char* cA = (const char*)g.A + (size_t)cur.pm * tstep; const char* cB = (const char*)g.Bt + (size_t)cur.pn * tstep;
    S.a_ready(cur);
    if constexpr (SP2) {
        PG8_STAGE(PG8_SB(0, 0), cB, voffB); PG8_STAGE(PG8_SB(0, 1), cB + hstep, voffB); PG8_STAGE(PG8_SA(0, 0), cA, voffA); PG8_STAGE(PG8_SA(0, 1), cA + hstep, voffA);
        if (wr == 1) PG8_BAR;
        PG8_WAIT_V(2); PG8_BAR;
        PG8_STAGE(PG8_SB(1, 0), cB + kstep, voffB); PG8_STAGE(PG8_SA(1, 0), cA + kstep, voffA); PG8_STAGE(PG8_SB(1, 1), cB + hstep + kstep, voffB);
        PG8_WAIT_V(6); PG8_BAR;
    } else {
        PG8_STAGE(PG8_SB(0, 0), cB, voffB); PG8_STAGE(PG8_SA(0, 0), cA, voffA); PG8_STAGE(PG8_SB(0, 1), cB + hstep, voffB); PG8_STAGE(PG8_SA(0, 1), cA + hstep, voffA);
        if (wr == 1) PG8_BAR;
        PG8_WAIT_V(4); PG8_BAR;
        PG8_STAGE(PG8_SB(1, 0), cB + kstep, voffB); PG8_STAGE(PG8_SA(1, 0), cA + kstep, voffA); PG8_STAGE(PG8_SB(1, 1), cB + hstep + kstep, voffB);
        PG8_WAIT_V(6); PG8_BAR;
    }
    for (;;) {
        const bool has_next = S.next(ui + 1, nxt);
        const char* nA = has_next ? (const char*)g.A + (size_t)nxt.pm * tstep : cA; const char* nB = has_next ? (const char*)g.Bt + (size_t)nxt.pn * tstep : cB;
        for (int t = 0; t < nt; t += 2) {
            const bool last = (t == nt - 2);
            const char* a1 = cA + (size_t)(t + 1) * kstep;
            const char* a2 = last ? nA : cA + (size_t)(t + 2) * kstep; const char* b2 = last ? nB : cB + (size_t)(t + 2) * kstep;
            const char* a3 = a2 + kstep; const char* b3 = b2 + kstep;
            if (last && has_next) S.a_ready(nxt);
            if constexpr (SP2) {
            PG8_LDB(B0, 0, 0); PG8_LDB(B1, 0, 1); PG8_SCHED; PG8_LDA(At, 0, 0); PG8_STAGE(PG8_SA(1, 1), a1 + hstep, voffA);
            PG8_WAIT_V(8); PG8_WAIT_L(0); PG8_BAR; PG8_MMA(0, 0, At, B0); PG8_MMA(0, 1, At, B1); PG8_BAR; PG8_SCHED;
            PG8_LDA(At, 0, 1); PG8_STAGE(PG8_SB(0, 0), b2, voffB); PG8_STAGE(PG8_SB(0, 1), b2 + hstep, voffB); PG8_STAGE(PG8_SA(0, 0), a2, voffA);
            PG8_WAIT_V(8); PG8_WAIT_L(0); PG8_BAR; PG8_MMA(1, 0, At, B0); PG8_MMA(1, 1, At, B1); PG8_BAR; PG8_SCHED;
            PG8_LDB(B0, 1, 0); PG8_LDB(B1, 1, 1); PG8_SCHED; PG8_LDA(At, 1, 0); PG8_STAGE(PG8_SA(0, 1), a2 + hstep, voffA);
            PG8_WAIT_V(8); PG8_WAIT_L(0); PG8_BAR; PG8_MMA(0, 0, At, B0); PG8_MMA(0, 1, At, B1); PG8_BAR; PG8_SCHED;
            PG8_LDA(At, 1, 1); PG8_STAGE(PG8_SB(1, 0), b3, voffB); PG8_STAGE(PG8_SB(1, 1), b3 + hstep, voffB); PG8_STAGE(PG8_SA(1, 0), a3, voffA);
            PG8_WAIT_V(8); PG8_WAIT_L(0); PG8_BAR; PG8_MMA(1, 0, At, B0); PG8_MMA(1, 1, At, B1); PG8_BAR; PG8_SCHED;
            } else {
            PG8_LDB(B0, 0, 0); PG8_SCHED; PG8_LDA(At, 0, 0); PG8_STAGE(PG8_SA(1, 1), a1 + hstep, voffA);
            PG8_WAIT_L(8); PG8_BAR; PG8_WAIT_L(0); PG8_MMA(0, 0, At, B0); PG8_BAR; PG8_SCHED;
            PG8_LDB(B1, 0, 1); PG8_STAGE(PG8_SB(0, 0), b2, voffB);
            PG8_BAR; PG8_WAIT_L(0); PG8_MMA(0, 1, At, B1); PG8_BAR;
            PG8_LDA(At, 0, 1); PG8_STAGE(PG8_SA(0, 0), a2, voffA);
            PG8_BAR; PG8_WAIT_L(0); PG8_MMA(1, 0, At, B0); PG8_BAR; PG8_SCHED;
            PG8_STAGE(PG8_SB(0, 1), b2 + hstep, voffB);
            PG8_WAIT_V(6); PG8_BAR; PG8_MMA(1, 1, At, B1); PG8_BAR;
            PG8_LDB(B0, 1, 0); PG8_SCHED; PG8_LDA(At, 1, 0); PG8_STAGE(PG8_SA(0, 1), a2 + hstep, voffA);
            PG8_WAIT_L(8); PG8_BAR; PG8_WAIT_L(0); PG8_MMA(0, 0, At, B0); PG8_BAR; PG8_SCHED;
            PG8_LDB(B1, 1, 1); PG8_STAGE(PG8_SB(1, 0), b3, voffB);
            PG8_BAR; PG8_WAIT_L(0); PG8_MMA(0, 1, At, B1); PG8_BAR;
            PG8_LDA(At, 1, 1); PG8_STAGE(PG8_SA(1, 0), a3, voffA);
            PG8_BAR; PG8_WAIT_L(0); PG8_MMA(1, 0, At, B0); PG8_BAR; PG8_SCHED;
            PG8_STAGE(PG8_SB(1, 1), b3 + hstep, voffB);
            PG8_WAIT_V(6); PG8_BAR; PG8_MMA(1, 1, At, B1); PG8_BAR;
            }
        }
        if constexpr (ALIGN_EPI) { if (wr == 0) PG8_BAR; }
        if constexpr (!Epi::AFTER_DRAIN) { E(acc, cur, wr, wc, fr, fq); S.done(cur); }
        if (!has_next) break;
#pragma unroll
        for (int a = 0; a < 2; ++a)
#pragma unroll
            for (int b = 0; b < 2; ++b)
#pragma unroll
                for (int m = 0; m < 4; ++m)
#pragma unroll
                    for (int n = 0; n < 2; ++n) acc[a][b][m][n] = (f32x4){0.f, 0.f, 0.f, 0.f};
        cur = nxt; cA = nA; cB = nB; ++ui;
        if constexpr (ALIGN_EPI) { if (wr == 1) PG8_BAR; }
    }
    PG8_WAIT_V(0);
    if constexpr (!ALIGN_EPI) { if (wr == 0) PG8_BAR; }
    PG8_BAR;
    if constexpr (Epi::AFTER_DRAIN) { E.fused(acc, cur, wr, wc, fr, fq, lds, wid, lane); S.done(cur); }
#undef PG8_SA
#undef PG8_SB
#undef PG8_STAGE
#undef PG8_LDA
#undef PG8_LDB
#undef PG8_MMA
#undef PG8_WAIT_V
#undef PG8_WAIT_L
#undef PG8_BAR
#undef PG8_SCHED
}
}
#define LAS __attribute__((address_space(3)))
typedef unsigned short bf16_t;
typedef float f32x4 __attribute__((ext_vector_type(4)));
typedef float f32x16 __attribute__((ext_vector_type(16)));
typedef unsigned u32x4 __attribute__((ext_vector_type(4)));
typedef unsigned u32x2 __attribute__((ext_vector_type(2)));
typedef short bf16x8 __attribute__((ext_vector_type(8)));

constexpr int TP = 16384, NSB = 16, TSS = 16, PAST = 1024, MROWS = 16640, DM = 1024, DFF = 2816, NPROJ = 3584, RWP = 1792, NLORA = 1536, KLORA = 256;
constexpr float LOG2E = 1.4426950408889634f;
constexpr float QSCALE = 0.125f * LOG2E;
constexpr size_t OFF_KP = 17039360, OFF_VP = 25427968, OFF_LFP = 33816576, OFF_STP = 33947648, OFF_SHP = 33980416, OFF_KS = 33982208, OFF_VS = 34113280,
                 OFF_LFS = 34244352, OFF_STS = 34246400, OFF_SHS = 34770688, OUT_TOTAL = 34799360;
constexpr size_t MiB = 1u << 20;
constexpr size_t WS_ROWSQ0 = 0, WS_ROWSQ1 = 128 * 1024, WS_ROWSQ2 = 256 * 1024, WS_TT = 384 * 1024;
constexpr size_t WS_LOGF = 1 * MiB, WS_CUM = 2 * MiB;
constexpr size_t WS_W1I = 3 * MiB, WS_W1O = 14 * MiB, WS_WIN = 20 * MiB, WS_WOUT = 27 * MiB, WS_W2I = 29 * MiB, WS_W2O = 40 * MiB, WS_WLORA = 46 * MiB;
constexpr size_t WS_XB = 47 * MiB;
constexpr size_t WS_Q = 80 * MiB, WS_K = 97 * MiB, WS_V = 114 * MiB;
constexpr size_t WS_X2B = 80 * MiB;
constexpr size_t WS_H = 131 * MiB;
constexpr size_t WS_PRW = 131 * MiB, WS_LORAA = 188 * MiB, WS_LORA = 197 * MiB;
constexpr size_t WS_SEG = 246 * MiB, WS_END = 256 * MiB;

struct Args { const float* in[30]; float* out; unsigned char* ws; };
typedef const __attribute__((address_space(4))) Args* CArgsP;
__device__ __forceinline__ CArgsP get_args() { CArgsP p = (CArgsP)__builtin_amdgcn_kernarg_segment_ptr(); asm volatile("" : "+s"(p)); return p; }

#define LDS_WAIT() asm volatile("s_waitcnt lgkmcnt(0)" ::: "memory")
__device__ __forceinline__ unsigned f2bf(float f) { unsigned u = __builtin_bit_cast(unsigned, f); return (u + 0x7fffu + ((u >> 16) & 1u)) >> 16; }
__device__ __forceinline__ unsigned pk2(float lo, float hi) { return f2bf(lo) | (f2bf(hi) << 16); }
__device__ __forceinline__ float bf2f(unsigned b) { return __builtin_bit_cast(float, b << 16); }
__device__ __forceinline__ float wave_sum(float v) {
#pragma unroll
    for (int o = 1; o < 64; o <<= 1) v += __shfl_xor(v, o);
    return v;
}
__device__ __forceinline__ float wave_max(float v) {
#pragma unroll
    for (int o = 1; o < 64; o <<= 1) v = fmaxf(v, __shfl_xor(v, o));
    return v;
}
template <int CTRL> __device__ __forceinline__ float dpp_f(float x) { return __builtin_bit_cast(float, __builtin_amdgcn_mov_dpp(__builtin_bit_cast(int, x), CTRL, 0xf, 0xf, true)); }
__device__ __forceinline__ float allred8(float x) { x += dpp_f<0xB1>(x); x += dpp_f<0x4E>(x); x += dpp_f<0x141>(x); return x; }

__device__ __forceinline__ void p0_item(const float* __restrict__ W, int K, int ldn, int nsrc0, int nvalid, const float* __restrict__ gain, bf16_t* WT, int dstrow0, int k0, LAS float* scr, int lane) {
    const int col = lane & 31;
#pragma unroll
    for (int i = 0; i < 32; ++i) {
        const int kk = 2 * i + (lane >> 5);
        float v = 0.f;
        if (col < nvalid) { v = W[(size_t)(k0 + kk) * ldn + nsrc0 + col]; if (gain) v *= gain[k0 + kk]; }
        scr[kk * 33 + col] = v;
    }
    LDS_WAIT();
    const int c = lane & 7;
#pragma unroll
    for (int j = 0; j < 4; ++j) {
        const int n = (lane >> 3) + 8 * j; const LAS float* s = scr + (8 * c) * 33 + n;
        u32x4 o; o.x = pk2(s[0 * 33], s[1 * 33]); o.y = pk2(s[2 * 33], s[3 * 33]); o.z = pk2(s[4 * 33], s[5 * 33]); o.w = pk2(s[6 * 33], s[7 * 33]);
        *(u32x4*)(WT + (size_t)(dstrow0 + n) * K + k0 + 8 * c) = o;
    }
    LDS_WAIT();
}

__device__ __forceinline__ void convert_tile(const float* __restrict__ W, int K, int ldn, const float* __restrict__ gain, bf16_t* WT, int pn, int k0, int kind, LAS unsigned char* lds, int wave, int lane) {
    LAS float* T = (LAS float*)lds;
    const int c = 4 * lane, q = c >> 5, db = 8 * pn + q;
    int nsrc0, nvalid = 32;
    if (kind == 0) nsrc0 = (q >> 2) * DFF + 128 * pn + 32 * (q & 3);
    else if (kind == 1) nsrc0 = 32 * db;
    else { const int l = 256 * pn + 64 * (q & 3) + 32 * (q >> 2); if (l < 1536) nsrc0 = l; else if (l < 3328) nsrc0 = l + 8; else { nsrc0 = 1536; nvalid = (l == 3328) ? 8 : 0; } }
    const bool ok = (c & 31) < nvalid;
    __syncthreads();
    f32x4 v[8];
#pragma unroll
    for (int i = 0; i < 8; ++i) { const int kk = 8 * wave + i; v[i] = (f32x4){0.f, 0.f, 0.f, 0.f}; if (ok) v[i] = *(const f32x4*)(W + (size_t)(k0 + kk) * ldn + nsrc0 + (c & 31)); }
#pragma unroll
    for (int i = 0; i < 8; ++i) { const int kk = 8 * wave + i; f32x4 t = v[i]; if (gain) t = t * gain[k0 + kk]; *(LAS f32x4*)(T + kk * 260 + c) = t; }
    __syncthreads();
    const int tid = wave * 64 + lane, n = tid & 255, hf = tid >> 8;
    u32x4 o[4];
#pragma unroll
    for (int j = 0; j < 4; ++j) {
        const LAS float* sp = T + (32 * hf + 8 * j) * 260 + n;
        o[j].x = pk2(sp[0 * 260], sp[1 * 260]); o[j].y = pk2(sp[2 * 260], sp[3 * 260]); o[j].z = pk2(sp[4 * 260], sp[5 * 260]); o[j].w = pk2(sp[6 * 260], sp[7 * 260]);
    }
    u32x4* dst = (u32x4*)(WT + (size_t)(256 * pn + n) * K + k0 + 32 * hf);
#pragma unroll
    for (int j = 0; j < 4; ++j) dst[j] = o[j];
}
__device__ __forceinline__ void convert_weights(CArgsP a, LAS unsigned char* lds, int wave, int lane, int which, int gb, int NGB) {
    unsigned char* ws = a->ws;
    constexpr int I0 = 22 * 16, I1 = 4 * 44, I2 = 14 * 16, I3 = 4 * 16;
    const int NIT = which == 0 ? I0 + I1 + I2 : I0 + I1 + I3;
    for (int it = gb; it < NIT; it += NGB) {
        int r = it;
        if (r < I0) { const int pn = r >> 4, kb = r & 15;
            convert_tile(which == 0 ? a->in[8] : a->in[28], 1024, 5632, which == 0 ? a->in[7] : a->in[27], (bf16_t*)(ws + (which == 0 ? WS_W1I : WS_W2I)), pn, 64 * kb, 0, lds, wave, lane); continue; }
        r -= I0;
        if (r < I1) { const int pn = r / 44, kb = r % 44; convert_tile(which == 0 ? a->in[9] : a->in[29], DFF, 1024, nullptr, (bf16_t*)(ws + (which == 0 ? WS_W1O : WS_W2O)), pn, 64 * kb, 1, lds, wave, lane); continue; }
        r -= I1;
        if (which == 0) { const int pn = r >> 4, kb = r & 15; convert_tile(a->in[11], 1024, 3336, a->in[10], (bf16_t*)(ws + WS_WIN), pn, 64 * kb, 2, lds, wave, lane); }
        else { const int pn = r >> 4, kb = r & 15; convert_tile(a->in[12], 1024, 1024, nullptr, (bf16_t*)(ws + WS_WOUT), pn, 64 * kb, 1, lds, wave, lane); }
    }
    __syncthreads();
}
__device__ __forceinline__ void phase0(CArgsP a, LAS unsigned char* lds, int wave, int lane) {
    const int gw = blockIdx.x * 8 + wave, NGW = gridDim.x * 8;
    unsigned char* ws = a->ws;
    convert_weights(a, lds, wave, lane, 0, blockIdx.x, gridDim.x);
    {
        bf16_t* WL = (bf16_t*)(ws + WS_WLORA);
        const int gt = blockIdx.x * 512 + threadIdx.x, NG = gridDim.x * 512;
        for (int idx = gt; idx < NLORA * KLORA; idx += NG) {
            const int n = idx >> 8, k = idx & 255; float v = 0.f;
            if (n < 512) { if (k < 64) v = a->in[18][k * 512 + n]; }
            else if (n < 1024) { if (k >= 64 && k < 128) v = a->in[20][(k - 64) * 512 + (n - 512)]; }
            else { if (k >= 128) v = a->in[21][(k - 128) * 512 + (n - 1024)]; }
            WL[idx] = (bf16_t)f2bf(v);
        }
    }
    {
        bf16_t* XB = (bf16_t*)(ws + WS_XB); float* rq0 = (float*)(ws + WS_ROWSQ0); float* rq1 = (float*)(ws + WS_ROWSQ1); float* rq2 = (float*)(ws + WS_ROWSQ2);
#pragma unroll 2
        for (int m = gw; m < MROWS; m += NGW) {
            const float* xrow = m < TP ? a->in[0] + (size_t)m * DM : a->in[1] + (size_t)(m - TP) * DM;
            const f32x4* xr = (const f32x4*)xrow + lane; f32x4 v[4]; float s = 0.f;
#pragma unroll
            for (int j = 0; j < 4; ++j) { v[j] = xr[64 * j]; s += (v[j].x * v[j].x + v[j].y * v[j].y) + (v[j].z * v[j].z + v[j].w * v[j].w); }
            s = wave_sum(s);
            u32x2* o8 = (u32x2*)(XB + (size_t)m * DM) + lane;
#pragma unroll
            for (int j = 0; j < 4; ++j) { u32x2 w; w.x = pk2(v[j].x, v[j].y); w.y = pk2(v[j].z, v[j].w); o8[64 * j] = w; }
            if (lane == 0) { rq0[m] = s; rq1[m] = 0.f; rq2[m] = 0.f; }
        }
    }
}

using pg8::cvt_pk_bf16;
struct EpiSwiglu {
    static constexpr bool PERM = true, AFTER_DRAIN = false;
    bf16_t* H; const float* rowsq;
    __device__ __forceinline__ void operator()(const pg8::f32x4 (&acc)[2][2][4][2], const pg8::Unit& u, int wr, int wc, int fr, int fq) const {
        const int row0 = u.pm * 256 + wr * 64 + fr, col0 = u.pn * 128 + wc * 32 + 8 * fq;
#pragma unroll
        for (int ai = 0; ai < 2; ++ai)
#pragma unroll
            for (int m = 0; m < 4; ++m) {
                const int row = row0 + ai * 128 + m * 16;
                const float rs = rsqrtf(rowsq[row] * (1.f / 1024.f) + 1e-6f);
                float h[8];
#pragma unroll
                for (int n = 0; n < 2; ++n)
#pragma unroll
                    for (int j = 0; j < 4; ++j) { const float g = acc[ai][0][m][n][j] * rs, up = acc[ai][1][m][n][j] * rs; h[4 * n + j] = g * __builtin_amdgcn_rcpf(1.f + __expf(-g)) * up; }
                u32x4 w; w.x = cvt_pk_bf16(h[0], h[1]); w.y = cvt_pk_bf16(h[2], h[3]); w.z = cvt_pk_bf16(h[4], h[5]); w.w = cvt_pk_bf16(h[6], h[7]);
                *(u32x4*)(H + (size_t)row * DFF + col0) = w;
            }
    }
};
struct EpiResid {
    static constexpr bool PERM = false, AFTER_DRAIN = false;
    const float* xp; const float* xs; float* Y; bf16_t* XB; float* rowsq_out; float scale; int inplace;
    __device__ __forceinline__ void operator()(const pg8::f32x4 (&acc)[2][2][4][2], const pg8::Unit& u, int wr, int wc, int fr, int fq) const {
        const int row0 = u.pm * 256 + wr * 64 + fr, col0 = u.pn * 256 + wc * 32 + 4 * fq;
#pragma unroll
        for (int ai = 0; ai < 2; ++ai)
#pragma unroll
            for (int m = 0; m < 4; ++m) {
                const int row = row0 + ai * 128 + m * 16;
                float* yo = Y + (size_t)row * DM;
                const float* base = inplace ? yo : (row < TP ? xp + (size_t)row * DM : xs + (size_t)(row - TP) * DM);
                float ss = 0.f;
#pragma unroll
                for (int bj = 0; bj < 2; ++bj)
#pragma unroll
                    for (int n = 0; n < 2; ++n) {
                        const int c = col0 + bj * 128 + n * 16;
                        const f32x4 b = *(const f32x4*)(base + c); const f32x4 o = b + acc[ai][bj][m][n] * scale;
                        *(f32x4*)(yo + c) = o;
                        if (XB) { u32x2 w; w.x = cvt_pk_bf16(o[0], o[1]); w.y = cvt_pk_bf16(o[2], o[3]); *(u32x2*)(XB + (size_t)row * DM + c) = w; }
                        ss += (o[0] * o[0] + o[1] * o[1]) + (o[2] * o[2] + o[3] * o[3]);
                    }
                if (rowsq_out) { ss += __shfl_xor(ss, 16); ss += __shfl_xor(ss, 32); if (fq == 0) atomicAdd(rowsq_out + row, ss); }
            }
    }
};
struct EpiProj {
    static constexpr bool PERM = true, AFTER_DRAIN = false;
    const float* rowsq; unsigned char* ws; float* out; const float *gq, *gk, *bfg;
    __device__ __forceinline__ void operator()(const pg8::f32x4 (&acc)[2][2][4][2], const pg8::Unit& u, int wr, int wc, int fr, int fq) const {
        const int row0 = u.pm * 256 + wr * 64 + fr, pn = u.pn;
        if (pn < 6) {
            const int kind = pn >> 1, head = (pn & 1) * 4 + wc, colh = head * 64 + 8 * fq;
            f32x4 gg[2][2];
#pragma unroll
            for (int bj = 0; bj < 2; ++bj)
#pragma unroll
                for (int n = 0; n < 2; ++n) {
                    gg[bj][n] = (f32x4){1.f, 1.f, 1.f, 1.f};
                    if (kind == 0) gg[bj][n] = *(const f32x4*)(gq + 32 * bj + 8 * fq + 4 * n) * QSCALE;
                    if (kind == 1) gg[bj][n] = *(const f32x4*)(gk + 32 * bj + 8 * fq + 4 * n);
                }
#pragma unroll
            for (int ai = 0; ai < 2; ++ai)
#pragma unroll
                for (int m = 0; m < 4; ++m) {
                    const int row = row0 + ai * 128 + m * 16;
                    const float rs = rsqrtf(rowsq[row] * (1.f / 1024.f) + 1e-6f);
                    f32x4 v[2][2]; float ss = 0.f;
#pragma unroll
                    for (int bj = 0; bj < 2; ++bj)
#pragma unroll
                        for (int n = 0; n < 2; ++n) { v[bj][n] = acc[ai][bj][m][n] * rs; const f32x4 t = v[bj][n]; ss += (t[0] * t[0] + t[1] * t[1]) + (t[2] * t[2] + t[3] * t[3]); }
                    if (kind < 2) {
                        ss += __shfl_xor(ss, 16); ss += __shfl_xor(ss, 32);
                        const float nrm = rsqrtf(ss * (1.f / 64.f) + 1e-6f);
#pragma unroll
                        for (int bj = 0; bj < 2; ++bj)
#pragma unroll
                            for (int n = 0; n < 2; ++n) v[bj][n] = v[bj][n] * nrm * gg[bj][n];
                    }
                    bf16_t* dstb = (bf16_t*)(ws + WS_Q + (size_t)kind * (WS_K - WS_Q)) + (size_t)row * 512 + colh;
#pragma unroll
                    for (int bj = 0; bj < 2; ++bj) {
                        u32x4 w; w.x = cvt_pk_bf16(v[bj][0][0], v[bj][0][1]); w.y = cvt_pk_bf16(v[bj][0][2], v[bj][0][3]); w.z = cvt_pk_bf16(v[bj][1][0], v[bj][1][1]); w.w = cvt_pk_bf16(v[bj][1][2], v[bj][1][3]);
                        *(u32x4*)(dstb + 32 * bj) = w;
                    }
                    if (kind >= 1) {
                        float* dstf = (row < TP ? out + OFF_KP + (size_t)(kind - 1) * (OFF_VP - OFF_KP) + (size_t)row * 512 : out + OFF_KS + (size_t)(kind - 1) * (OFF_VS - OFF_KS) + (size_t)(row - TP) * 512) + colh;
#pragma unroll
                        for (int bj = 0; bj < 2; ++bj) { __builtin_nontemporal_store(v[bj][0], (f32x4*)(dstf + 32 * bj)); __builtin_nontemporal_store(v[bj][1], (f32x4*)(dstf + 32 * bj + 4)); }
                    }
                }
        } else if (pn < 13) {
            const int colr = (pn - 6) * 256 + 64 * wc + 8 * fq;
#pragma unroll
            for (int ai = 0; ai < 2; ++ai)
#pragma unroll
                for (int m = 0; m < 4; ++m) {
                    const int row = row0 + ai * 128 + m * 16;
                    const float rs = rsqrtf(rowsq[row] * (1.f / 1024.f) + 1e-6f);
                    const bool last = (row == TP - 1) || (row >= TP && ((row - TP) & 15) == 15);
                    float* dstf = (row < TP ? out + OFF_SHP : out + OFF_SHS + (size_t)((row - TP) >> 4) * RWP) + colr;
#pragma unroll
                    for (int bj = 0; bj < 2; ++bj) {
                        const f32x4 v0 = acc[ai][bj][m][0] * rs, v1 = acc[ai][bj][m][1] * rs;
                        u32x4 w; w.x = cvt_pk_bf16(v0[0], v0[1]); w.y = cvt_pk_bf16(v0[2], v0[3]); w.z = cvt_pk_bf16(v1[0], v1[1]); w.w = cvt_pk_bf16(v1[2], v1[3]);
                        *(u32x4*)((bf16_t*)(ws + WS_PRW) + (size_t)row * RWP + colr + 32 * bj) = w;
                        if (last) { *(f32x4*)(dstf + 32 * bj) = v0; *(f32x4*)(dstf + 32 * bj + 4) = v1; }
                    }
                }
        } else {
            if (wc == 0 && fq == 0) {
                const f32x4 b0 = *(const f32x4*)(bfg), b1 = *(const f32x4*)(bfg + 4);
#pragma unroll
                for (int ai = 0; ai < 2; ++ai)
#pragma unroll
                    for (int m = 0; m < 4; ++m) {
                        const int row = row0 + ai * 128 + m * 16;
                        const float rs = rsqrtf(rowsq[row] * (1.f / 1024.f) + 1e-6f);
                        const f32x4 z0 = acc[ai][0][m][0] * rs + b0, z1 = acc[ai][0][m][1] * rs + b1;
                        f32x4 l0, l1;
#pragma unroll
                        for (int j = 0; j < 4; ++j) { l0[j] = fminf(z0[j], 0.f) - __logf(1.f + __expf(-fabsf(z0[j]))); l1[j] = fminf(z1[j], 0.f) - __logf(1.f + __expf(-fabsf(z1[j]))); }
                        float* LOGF = (float*)(ws + WS_LOGF); *(f32x4*)(LOGF + (size_t)row * 8) = l0; *(f32x4*)(LOGF + (size_t)row * 8 + 4) = l1;
                        float* dstf = row < TP ? out + OFF_LFP + (size_t)row * 8 : out + OFF_LFS + (size_t)(row - TP) * 8;
                        *(f32x4*)dstf = l0; *(f32x4*)(dstf + 4) = l1;
                    }
            }
        }
    }
};
struct EpiBf16N {
    static constexpr bool PERM = true, AFTER_DRAIN = false;
    bf16_t* O; int ldc;
    __device__ __forceinline__ void operator()(const pg8::f32x4 (&acc)[2][2][4][2], const pg8::Unit& u, int wr, int wc, int fr, int fq) const {
        const int row0 = u.pm * 256 + wr * 64 + fr, col0 = u.pn * 256 + wc * 32 + 8 * fq;
#pragma unroll
        for (int ai = 0; ai < 2; ++ai)
#pragma unroll
            for (int m = 0; m < 4; ++m) {
                bf16_t* rowp = O + (size_t)(row0 + ai * 128 + m * 16) * ldc + col0;
#pragma unroll
                for (int bj = 0; bj < 2; ++bj) {
                    const f32x4 v0 = acc[ai][bj][m][0], v1 = acc[ai][bj][m][1];
                    u32x4 w; w.x = cvt_pk_bf16(v0[0], v0[1]); w.y = cvt_pk_bf16(v0[2], v0[3]); w.z = cvt_pk_bf16(v1[0], v1[1]); w.w = cvt_pk_bf16(v1[2], v1[3]);
                    *(u32x4*)(rowp + bj * 128) = w;
                }
            }
    }
};

__device__ __forceinline__ void phase4(CArgsP a, int wave, int lane) {
    unsigned char* ws = a->ws;
    const bf16_t* PRW = (const bf16_t*)(ws + WS_PRW); bf16_t* LA = (bf16_t*)(ws + WS_LORAA);
    const int gw = blockIdx.x * 8 + wave, NGW = gridDim.x * 8;
    const f32x4 mu = *(const f32x4*)(a->in[16] + 1536 + 4 * lane);
#pragma unroll 8
    for (int m = gw; m < MROWS; m += NGW) {
        const u32x2 pw = *(const u32x2*)(PRW + (size_t)m * RWP + 1536 + 4 * lane);
        f32x4 p = {bf2f(pw.x & 0xffffu), bf2f(pw.x >> 16), bf2f(pw.y & 0xffffu), bf2f(pw.y >> 16)};
        f32x4 q = {0.f, 0.f, 0.f, 0.f};
        const bool first = (m == 0) || (m >= TP && ((m - TP) & 15) == 0);
        if (!first) { const u32x2 qw = *(const u32x2*)(PRW + (size_t)(m - 1) * RWP + 1536 + 4 * lane); q = (f32x4){bf2f(qw.x & 0xffffu), bf2f(qw.x >> 16), bf2f(qw.y & 0xffffu), bf2f(qw.y >> 16)}; }
        else if (m >= TP) q = *(const f32x4*)(a->in[6] + (size_t)((m - TP) >> 4) * RWP + 1536 + 4 * lane);
        const f32x4 xs = p + (q - p) * mu;
        float o[4];
#pragma unroll
        for (int j = 0; j < 4; ++j) { const float e = __expf(lane < 16 ? 2.f * xs[j] : -xs[j]); const float rc = __builtin_amdgcn_rcpf(1.f + e); o[j] = lane < 16 ? 1.f - 2.f * rc : (lane < 32 ? xs[j] : rc); }
        u32x2 w; w.x = pk2(o[0], o[1]); w.y = pk2(o[2], o[3]);
        *(u32x2*)(LA + (size_t)m * KLORA + 4 * lane) = w;
    }
    if (blockIdx.x < 64) {
        const float* LOGF = (const float*)(ws + WS_LOGF); float* CUM = (float*)(ws + WS_CUM); float* TT = (float*)(ws + WS_TT);
        const int tile = blockIdx.x, h = wave, t0 = tile * 256 + 4 * lane;
        float v0 = LOGF[(size_t)(t0 + 0) * 8 + h], v1 = LOGF[(size_t)(t0 + 1) * 8 + h], v2 = LOGF[(size_t)(t0 + 2) * 8 + h], v3 = LOGF[(size_t)(t0 + 3) * 8 + h];
        v1 += v0; v2 += v1; v3 += v2;
        float inc = v3;
#pragma unroll
        for (int o = 1; o < 64; o <<= 1) { const float t = __shfl_up(inc, o); if (lane >= o) inc += t; }
        const float excl = inc - v3;
        CUM[(size_t)(t0 + 0) * 8 + h] = excl + v0; CUM[(size_t)(t0 + 1) * 8 + h] = excl + v1; CUM[(size_t)(t0 + 2) * 8 + h] = excl + v2; CUM[(size_t)(t0 + 3) * 8 + h] = excl + v3;
        if (lane == 63) TT[tile * 8 + h] = inc;
    }
}
__device__ __forceinline__ void cum_fixup(CArgsP a) {
    if (blockIdx.x < 64) {
        float* CUM = (float*)(a->ws + WS_CUM); const float* TT = (const float*)(a->ws + WS_TT);
        const int tile = blockIdx.x, h = threadIdx.x & 7;
        float pre = 0.f;
        for (int t = 0; t < tile; ++t) pre += TT[t * 8 + h];
#pragma unroll
        for (int i = 0; i < 4; ++i) { const int idx = threadIdx.x + 512 * i; CUM[(size_t)tile * 2048 + idx] += pre; }
    }
}

constexpr int AT_KVBUF = 17664, AT_VT = 8192, AT_CK = 17408, AT_MISC = 2 * AT_KVBUF, AT_VS = 144;
__device__ __forceinline__ int slotpos(int kv) { const int w = kv & 15; return (kv & ~15) + 8 * ((w >> 2) & 1) + (w & 3) + ((w >> 3) << 2); }
__device__ __forceinline__ void attn_unit(LAS unsigned char* lds, CArgsP a, int h, int qb, float thr) {
    const int tid = threadIdx.x, lane = tid & 63, wid = tid >> 6, r32 = lane & 31, hi = lane >> 5;
    const bf16_t* QB = (const bf16_t*)(a->ws + WS_Q); const bf16_t* KB = (const bf16_t*)(a->ws + WS_K); const bf16_t* VB = (const bf16_t*)(a->ws + WS_V);
    const float* CUM = (const float*)(a->ws + WS_CUM); bf16_t* MIX = (bf16_t*)(a->ws + WS_XB);
    const int q0 = qb * 256, qrow = q0 + wid * 32 + r32;
    bf16x8 qr[4];
#pragma unroll
    for (int d0 = 0; d0 < 4; ++d0) qr[d0] = *(const bf16x8*)(QB + (size_t)qrow * 512 + h * 64 + d0 * 16 + hi * 8);
    const float cref = CUM[(size_t)q0 * 8 + h];
    const int jt_hi = 4 * qb + 3;
    LAS int* s_lo = (LAS int*)(lds + AT_MISC);
    __syncthreads();
    if (tid == 0) *s_lo = 4 * qb;
    __syncthreads();
    {
        const float cq0 = cref;
        if (tid < 4 * qb) { const float cj = CUM[(size_t)(64 * tid + 63) * 8 + h]; if (cq0 - cj >= -thr) atomicMin((int*)s_lo, tid); }
    }
    __syncthreads();
    const int jt_lo = *s_lo;
    const int kvl = tid & 63, ch = tid >> 6;
    u32x4 kreg, vreg; float ckreg = 0.f;
    auto gload = [&](int jt) {
        const size_t off = (size_t)(64 * jt + kvl) * 512 + h * 64 + ch * 8;
        kreg = *(const u32x4*)(KB + off); vreg = *(const u32x4*)(VB + off);
        if (tid < 64) ckreg = (CUM[(size_t)(64 * jt + tid) * 8 + h] - cref) * LOG2E;
    };
    u32x4 kreg2, vreg2; float ckreg2 = 0.f;
    auto gload2 = [&](int jt) {
        const size_t off = (size_t)(64 * jt + kvl) * 512 + h * 64 + ch * 8;
        kreg2 = *(const u32x4*)(KB + off); vreg2 = *(const u32x4*)(VB + off);
        if (tid < 64) ckreg2 = (CUM[(size_t)(64 * jt + tid) * 8 + h] - cref) * LOG2E;
    };
    const int sp2 = 2 * slotpos(kvl);
    auto lstore = [&](int b) {
        LAS unsigned char* buf = lds + b * AT_KVBUF;
        *(LAS u32x4*)(buf + ch * 1024 + kvl * 16) = kreg;
        LAS unsigned char* vt = buf + AT_VT + (8 * ch) * AT_VS + sp2;
        *(LAS unsigned short*)(vt + 0 * AT_VS) = (unsigned short)(vreg.x & 0xffffu); *(LAS unsigned short*)(vt + 1 * AT_VS) = (unsigned short)(vreg.x >> 16);
        *(LAS unsigned short*)(vt + 2 * AT_VS) = (unsigned short)(vreg.y & 0xffffu); *(LAS unsigned short*)(vt + 3 * AT_VS) = (unsigned short)(vreg.y >> 16);
        *(LAS unsigned short*)(vt + 4 * AT_VS) = (unsigned short)(vreg.z & 0xffffu); *(LAS unsigned short*)(vt + 5 * AT_VS) = (unsigned short)(vreg.z >> 16);
        *(LAS unsigned short*)(vt + 6 * AT_VS) = (unsigned short)(vreg.w & 0xffffu); *(LAS unsigned short*)(vt + 7 * AT_VS) = (unsigned short)(vreg.w >> 16);
        if (tid < 64) *(LAS float*)(buf + AT_CK + 4 * tid) = ckreg;
    };
    gload(jt_hi); lstore(0);
    if (jt_lo < jt_hi) gload(jt_hi - 1);
    __syncthreads();
    float m_run = -INFINITY, l_run = 0.f;
    f32x16 o0 = {}, o1 = {};
    for (int jt = jt_hi; jt >= jt_lo; --jt) {
        const int b = (jt_hi - jt) & 1;
        if (jt - 2 >= jt_lo) gload2(jt - 2);
        LAS unsigned char* buf = lds + b * AT_KVBUF;
        if (64 * (jt - 4 * qb) <= 32 * wid + 31) {
        f32x16 p0 = {}, p1 = {};
#pragma unroll
        for (int d0 = 0; d0 < 4; ++d0) {
            const bf16x8 a0 = *(const LAS bf16x8*)(buf + (2 * d0 + hi) * 1024 + r32 * 16);
            const bf16x8 a1 = *(const LAS bf16x8*)(buf + (2 * d0 + hi) * 1024 + (32 + r32) * 16);
            p0 = __builtin_amdgcn_mfma_f32_32x32x16_bf16(a0, qr[d0], p0, 0, 0, 0);
            p1 = __builtin_amdgcn_mfma_f32_32x32x16_bf16(a1, qr[d0], p1, 0, 0, 0);
        }
        const int kvb = 64 * jt;
        float mx = -INFINITY;
        if (jt < 4 * qb) {
#pragma unroll
            for (int g = 0; g < 4; ++g) {
                const f32x4 c0 = *(const LAS f32x4*)(buf + AT_CK + 4 * (8 * g + 4 * hi));
                const f32x4 c1 = *(const LAS f32x4*)(buf + AT_CK + 4 * (32 + 8 * g + 4 * hi));
#pragma unroll
                for (int j = 0; j < 4; ++j) { const float s0 = p0[4 * g + j] - c0[j], s1 = p1[4 * g + j] - c1[j]; p0[4 * g + j] = s0; p1[4 * g + j] = s1; mx = fmaxf(mx, fmaxf(s0, s1)); }
            }
        } else {
#pragma unroll
            for (int g = 0; g < 4; ++g) {
                const f32x4 c0 = *(const LAS f32x4*)(buf + AT_CK + 4 * (8 * g + 4 * hi));
                const f32x4 c1 = *(const LAS f32x4*)(buf + AT_CK + 4 * (32 + 8 * g + 4 * hi));
#pragma unroll
                for (int j = 0; j < 4; ++j) {
                    const int kv = kvb + 8 * g + 4 * hi + j;
                    float s0 = p0[4 * g + j] - c0[j]; if (kv > qrow) s0 = -INFINITY;
                    float s1 = p1[4 * g + j] - c1[j]; if (kv + 32 > qrow) s1 = -INFINITY;
                    p0[4 * g + j] = s0; p1[4 * g + j] = s1; mx = fmaxf(mx, fmaxf(s0, s1));
                }
            }
        }
        mx = fmaxf(mx, __shfl_xor(mx, 32));
        float ps = 0.f;
        if (__any(mx > m_run)) {
            const float m_new = fmaxf(m_run, mx);
            const float alpha = __builtin_amdgcn_exp2f(m_run - m_new);
            m_run = m_new;
            l_run *= alpha;
#pragma unroll
            for (int r = 0; r < 16; ++r) { o0[r] *= alpha; o1[r] *= alpha; }
        }
#pragma unroll
        for (int r = 0; r < 16; ++r) { p0[r] = __builtin_amdgcn_exp2f(p0[r] - m_run); p1[r] = __builtin_amdgcn_exp2f(p1[r] - m_run); ps += p0[r] + p1[r]; }
        l_run += ps;
        bf16x8 pf[4];
#pragma unroll
        for (int bb = 0; bb < 2; ++bb) {
            u32x4 w0, w1;
            w0.x = cvt_pk_bf16(p0[8 * bb + 0], p0[8 * bb + 1]); w0.y = cvt_pk_bf16(p0[8 * bb + 2], p0[8 * bb + 3]); w0.z = cvt_pk_bf16(p0[8 * bb + 4], p0[8 * bb + 5]); w0.w = cvt_pk_bf16(p0[8 * bb + 6], p0[8 * bb + 7]);
            w1.x = cvt_pk_bf16(p1[8 * bb + 0], p1[8 * bb + 1]); w1.y = cvt_pk_bf16(p1[8 * bb + 2], p1[8 * bb + 3]); w1.z = cvt_pk_bf16(p1[8 * bb + 4], p1[8 * bb + 5]); w1.w = cvt_pk_bf16(p1[8 * bb + 6], p1[8 * bb + 7]);
            pf[bb] = __builtin_bit_cast(bf16x8, w0); pf[2 + bb] = __builtin_bit_cast(bf16x8, w1);
        }
#pragma unroll
        for (int kb = 0; kb < 4; ++kb) {
            const bf16x8 v0 = *(const LAS bf16x8*)(buf + AT_VT + (r32) * AT_VS + (16 * kb + 8 * hi) * 2);
            const bf16x8 v1 = *(const LAS bf16x8*)(buf + AT_VT + (32 + r32) * AT_VS + (16 * kb + 8 * hi) * 2);
            o0 = __builtin_amdgcn_mfma_f32_32x32x16_bf16(v0, pf[kb], o0, 0, 0, 0);
            o1 = __builtin_amdgcn_mfma_f32_32x32x16_bf16(v1, pf[kb], o1, 0, 0, 0);
        }
        }
        if (jt > jt_lo) lstore(b ^ 1);
        asm volatile("s_waitcnt lgkmcnt(0)\n\ts_barrier" ::: "memory");
        kreg = kreg2; vreg = vreg2; ckreg = ckreg2;
    }
    const float lt = l_run + __shfl_xor(l_run, 32);
    const float inv = 1.f / lt;
    bf16_t* orow = MIX + (size_t)qrow * DM + h * 64 + 4 * hi;
#pragma unroll
    for (int g = 0; g < 4; ++g) {
        u32x2 w0, w1;
        w0.x = cvt_pk_bf16(o0[4 * g] * inv, o0[4 * g + 1] * inv); w0.y = cvt_pk_bf16(o0[4 * g + 2] * inv, o0[4 * g + 3] * inv);
        w1.x = cvt_pk_bf16(o1[4 * g] * inv, o1[4 * g + 1] * inv); w1.y = cvt_pk_bf16(o1[4 * g + 2] * inv, o1[4 * g + 3] * inv);
        *(u32x2*)(orow + 8 * g) = w0; *(u32x2*)(orow + 32 + 8 * g) = w1;
    }
}

constexpr int SA_C = 0, SA_Q = 4352, SA_SC = 8448, SA_NK = PAST + TSS;
__device__ __forceinline__ void attn_sample_unit(LAS unsigned char* lds, CArgsP a, int b, int h) {
    const int tid = threadIdx.x, lane = tid & 63, wid = tid >> 6;
    LAS float* C = (LAS float*)(lds + SA_C); LAS float* Qs = (LAS float*)(lds + SA_Q); LAS float* SC = (LAS float*)(lds + SA_SC);
    const float* LOGF = (const float*)(a->ws + WS_LOGF); const bf16_t* QB = (const bf16_t*)(a->ws + WS_Q); bf16_t* MIX = (bf16_t*)(a->ws + WS_XB);
    const float* ck = a->in[2]; const float* cv = a->in[3]; const float* clf = a->in[4];
    const float* nk = a->out + OFF_KS; const float* nv = a->out + OFF_VS;
    __syncthreads();
    if (wid == 0) {
        float v[17]; float run = 0.f;
#pragma unroll
        for (int i = 0; i < 17; ++i) {
            const int j = 17 * lane + i; float x = 0.f;
            if (j < PAST) x = clf[((size_t)b * PAST + j) * 8 + h]; else if (j < SA_NK) x = LOGF[(size_t)(TP + 16 * b + (j - PAST)) * 8 + h];
            run += x; v[i] = run;
        }
        float inc = run;
#pragma unroll
        for (int o = 1; o < 64; o <<= 1) { const float t = __shfl_up(inc, o); if (lane >= o) inc += t; }
        const float excl = inc - run;
#pragma unroll
        for (int i = 0; i < 17; ++i) { const int j = 17 * lane + i; if (j < SA_NK) C[j] = excl + v[i]; }
    } else {
        for (int i = tid - 64; i < 1024; i += 448) { const int t = i >> 6, d = i & 63; Qs[i] = bf2f(QB[(size_t)(TP + 16 * b + t) * 512 + h * 64 + d]); }
    }
    __syncthreads();
    for (int j = tid; j < SA_NK; j += 512) {
        const float* kp = j < PAST ? ck + (((size_t)b * PAST + j) * 8 + h) * 64 : nk + (size_t)(16 * b + (j - PAST)) * 512 + h * 64;
        float acc[16];
#pragma unroll
        for (int t = 0; t < 16; ++t) acc[t] = 0.f;
#pragma unroll
        for (int hb = 0; hb < 2; ++hb) {
            f32x4 kr[8];
#pragma unroll
            for (int i = 0; i < 8; ++i) kr[i] = *(const f32x4*)(kp + 32 * hb + 4 * i);
#pragma unroll
            for (int i = 0; i < 8; ++i) {
                asm volatile("" ::: "memory");
                const f32x4 k4 = kr[i];
#pragma unroll
                for (int t = 0; t < 16; ++t) { const f32x4 q4 = *(const LAS f32x4*)(Qs + t * 64 + 32 * hb + 4 * i); acc[t] += (q4[0] * k4[0] + q4[1] * k4[1]) + (q4[2] * k4[2] + q4[3] * k4[3]); }
            }
        }
        const float cj = C[j];
#pragma unroll
        for (int t = 0; t < 16; ++t) SC[t * SA_NK + j] = acc[t] + (C[PAST + t] - cj) * LOG2E;
    }
    __syncthreads();
#pragma unroll
    for (int tt = 0; tt < 2; ++tt) {
        const int t = 2 * wid + tt; LAS float* row = SC + t * SA_NK;
        float mx = -INFINITY;
        for (int j = lane; j < SA_NK; j += 64) { if (j > PAST + t) row[j] = -INFINITY; mx = fmaxf(mx, row[j]); }
        mx = wave_max(mx);
        float sum = 0.f;
        for (int j = lane; j < SA_NK; j += 64) { const float p = __builtin_amdgcn_exp2f(row[j] - mx); row[j] = p; sum += p; }
        sum = wave_sum(sum);
        const float inv = 1.f / sum;
        for (int j = lane; j < SA_NK; j += 64) row[j] *= inv;
    }
    __syncthreads();
    {
        float acc[16];
#pragma unroll
        for (int t = 0; t < 16; ++t) acc[t] = 0.f;
        const float* vp = cv + ((size_t)b * PAST * 8 + h) * 64 + lane;
        float vv[8], vn8[8];
#pragma unroll
        for (int i = 0; i < 8; ++i) vv[i] = vp[(size_t)(wid + 8 * i) * 512];
#pragma unroll 1
        for (int j0 = wid; j0 < PAST; j0 += 64) {
            const int jn = (j0 + 64 < PAST) ? j0 + 64 : j0;
#pragma unroll
            for (int i = 0; i < 8; ++i) vn8[i] = vp[(size_t)(jn + 8 * i) * 512];
#pragma unroll
            for (int i = 0; i < 8; ++i) {
                asm volatile("" ::: "memory");
#pragma unroll
                for (int t = 0; t < 16; ++t) acc[t] += SC[t * SA_NK + j0 + 8 * i] * vv[i];
            }
#pragma unroll
            for (int i = 0; i < 8; ++i) vv[i] = vn8[i];
        }
        {
            const float* vn = nv + (size_t)(16 * b) * 512 + h * 64 + lane;
            const float v0 = vn[(size_t)wid * 512], v1 = vn[(size_t)(wid + 8) * 512];
#pragma unroll
            for (int t = 0; t < 16; ++t) acc[t] += SC[t * SA_NK + PAST + wid] * v0 + SC[t * SA_NK + PAST + wid + 8] * v1;
        }
        __syncthreads();
        LAS float* red = SC;
#pragma unroll
        for (int t = 0; t < 16; ++t) red[(wid * 16 + t) * 64 + lane] = acc[t];
        __syncthreads();
        {
            const int t = tid >> 5, d = 2 * (tid & 31);
            float a0 = 0.f, a1 = 0.f;
#pragma unroll
            for (int w = 0; w < 8; ++w) { a0 += red[(w * 16 + t) * 64 + d]; a1 += red[(w * 16 + t) * 64 + d + 1]; }
            *(unsigned*)(MIX + (size_t)(TP + 16 * b + t) * DM + h * 64 + d) = pk2(a0, a1);
        }
    }
}

constexpr int NSEG = 64, SEGCH = TP / 16 / NSEG;
constexpr size_t WS_PM = WS_SEG, WS_UM = WS_W1I, WS_SS = WS_LORAA;
constexpr int SC_CHB = 7 * 16 * 64 * 4, SC_Y = 2 * SC_CHB, SC_HALF = SC_Y + 16 * 64 * 4;
static_assert(2 * SC_HALF <= 131072, "scan LDS");
__device__ __forceinline__ float wave_sum_fast(float x) {
    x += dpp_f<0xB1>(x); x += dpp_f<0x4E>(x); x += dpp_f<0x141>(x); x += dpp_f<0x140>(x);
    x += __builtin_bit_cast(float, __builtin_amdgcn_update_dpp(0, __builtin_bit_cast(int, x), 0x142, 0xa, 0xf, false));
    x += __builtin_bit_cast(float, __builtin_amdgcn_update_dpp(0, __builtin_bit_cast(int, x), 0x143, 0xc, 0xf, false));
    return __builtin_bit_cast(float, __builtin_amdgcn_readlane(__builtin_bit_cast(int, x), 63));
}
struct ScanRaw { unsigned prk[4], pvq[4], qkv[4], lwa[4]; unsigned short lg[4]; };
struct ScanUnit { int seq, h, c0; const float* S0; float* Sout; float* Pout; };
typedef float f32x2 __attribute__((ext_vector_type(2)));
struct V8 { f32x2 p[4]; };
__device__ __forceinline__ V8 ld8(const LAS float* p) {
    const f32x4 a = *(const LAS f32x4*)p, b = *(const LAS f32x4*)(p + 4);
    V8 r; r.p[0] = __builtin_shufflevector(a, a, 0, 1); r.p[1] = __builtin_shufflevector(a, a, 2, 3); r.p[2] = __builtin_shufflevector(b, b, 0, 1); r.p[3] = __builtin_shufflevector(b, b, 2, 3); return r;
}
__device__ __forceinline__ float dot8(const V8& S, const V8& k) { f32x2 acc = S.p[0] * k.p[0]; acc = S.p[1] * k.p[1] + acc; acc = S.p[2] * k.p[2] + acc; acc = S.p[3] * k.p[3] + acc; return acc.x + acc.y; }
__device__ __forceinline__ float red8(float d) { d += dpp_f<0xB1>(d); d += dpp_f<0x4E>(d); d += dpp_f<0x141>(d); return d; }
__device__ __forceinline__ void upd8(V8& S, const V8& w, const V8& b, const V8& k, float sa, float vv) {
    const f32x2 sa2 = {sa, sa}, vv2 = {vv, vv};
#pragma unroll
    for (int i = 0; i < 4; ++i) { f32x2 t = vv2 * k.p[i]; t = sa2 * b.p[i] + t; S.p[i] = S.p[i] * w.p[i] + t; }
}
__device__ __forceinline__ void updp8(V8& S, const V8& w, const V8& b, float sa) {
    const f32x2 sa2 = {sa, sa};
#pragma unroll
    for (int i = 0; i < 4; ++i) { const f32x2 t = sa2 * b.p[i]; S.p[i] = S.p[i] * w.p[i] + t; }
}
template <int MODE>
__device__ __forceinline__ void scan_pair(LAS unsigned char* lds, CArgsP a, const ScanUnit u, int nch) {
    const int tid = threadIdx.x, lane = tid & 63, wid = tid >> 6, half = wid >> 2, hw = wid & 3, ks = lane & 7, vr0 = hw * 16 + (lane >> 3), vr1 = vr0 + 8;
    LAS unsigned char* hl = lds + half * SC_HALF;
    const bf16_t* PRW = (const bf16_t*)(a->ws + WS_PRW); const bf16_t* LORA = (const bf16_t*)(a->ws + WS_LORA); bf16_t* MIX = (bf16_t*)(a->ws + WS_XB);
    const int seq = u.seq, h = u.h, c0 = u.c0;
    const int rowbase = seq == 0 ? 0 : TP + 16 * (seq - 1);
    const int c_ = h * 64 + lane;
    const float mu_r = a->in[16][c_], mu_k = a->in[16][512 + c_], mu_v = a->in[16][1024 + c_], w0c = a->in[17][c_], a0c = a->in[19][c_];
    const float kkc = a->in[22][c_], kac = a->in[23][c_], rkc = a->in[24][c_], lng = a->in[25][c_], lnb = a->in[26][c_];
    V8 Sa, Sb, Pa, Pb;
#pragma unroll
    for (int i = 0; i < 4; ++i) {
        Sa.p[i] = (f32x2){0.f, 0.f}; Sb.p[i] = (f32x2){0.f, 0.f};
        Pa.p[i] = (f32x2){(8 * ks + 2 * i == vr0) ? 1.f : 0.f, (8 * ks + 2 * i + 1 == vr0) ? 1.f : 0.f};
        Pb.p[i] = (f32x2){(8 * ks + 2 * i == vr1) ? 1.f : 0.f, (8 * ks + 2 * i + 1 == vr1) ? 1.f : 0.f};
    }
    if (u.S0) {
        const float* sp = u.S0 + (size_t)vr0 * 64 + 8 * ks;
        const f32x4 s0 = *(const f32x4*)sp, s1 = *(const f32x4*)(sp + 4), s2 = *(const f32x4*)(sp + 512), s3 = *(const f32x4*)(sp + 516);
        Sa.p[0] = (f32x2){s0[0], s0[1]}; Sa.p[1] = (f32x2){s0[2], s0[3]}; Sa.p[2] = (f32x2){s1[0], s1[1]}; Sa.p[3] = (f32x2){s1[2], s1[3]};
        Sb.p[0] = (f32x2){s2[0], s2[1]}; Sb.p[1] = (f32x2){s2[2], s2[3]}; Sb.p[2] = (f32x2){s3[0], s3[1]}; Sb.p[3] = (f32x2){s3[2], s3[3]};
    }
    __syncthreads();
    ScanRaw R;
    float sh0[3];
    auto rawload = [&](int c) {
#pragma unroll
        for (int tt = 0; tt < 4; ++tt) {
            const int tl = 16 * c + 4 * hw + tt; const size_t m = (size_t)rowbase + tl;
            const unsigned pr = PRW[m * RWP + c_], pk = PRW[m * RWP + 512 + c_], pv = PRW[m * RWP + 1024 + c_];
            unsigned qr = 0, qk = 0, qv = 0;
            if (tl > 0) { qr = PRW[(m - 1) * RWP + c_]; qk = PRW[(m - 1) * RWP + 512 + c_]; qv = PRW[(m - 1) * RWP + 1024 + c_]; }
            else {
                sh0[0] = 0.f; sh0[1] = 0.f; sh0[2] = 0.f;
                if (seq > 0) { const float* s0 = a->in[6] + (size_t)(seq - 1) * RWP; sh0[0] = s0[c_]; sh0[1] = s0[512 + c_]; sh0[2] = s0[1024 + c_]; }
            }
            const unsigned lw = LORA[m * NLORA + c_], la = LORA[m * NLORA + 512 + c_];
            R.prk[tt] = pr | (pk << 16); R.pvq[tt] = pv | (qr << 16); R.qkv[tt] = qk | (qv << 16); R.lwa[tt] = lw | (la << 16);
            R.lg[tt] = LORA[m * NLORA + 1024 + c_];
        }
    };
    auto prep = [&](int c, int b) {
        LAS float* cb = (LAS float*)(hl + b * SC_CHB);
#pragma unroll
        for (int tt = 0; tt < 4; ++tt) {
            const int t = 4 * hw + tt, tl = 16 * c + t;
            const float pr = bf2f(R.prk[tt] & 0xffffu), pk = bf2f(R.prk[tt] >> 16), pv = bf2f(R.pvq[tt] & 0xffffu);
            float qr = bf2f(R.pvq[tt] >> 16), qk = bf2f(R.qkv[tt] & 0xffffu), qv = bf2f(R.qkv[tt] >> 16);
            if (tl == 0) { qr = sh0[0]; qk = sh0[1]; qv = sh0[2]; }
            const float xr = pr + (qr - pr) * mu_r, xk = pk + (qk - pk) * mu_k, xv = pv + (qv - pv) * mu_v;
            const float wp = w0c + bf2f(R.lwa[tt] & 0xffffu);
            const float w = __expf(-0.6065306597126334f * __builtin_amdgcn_rcpf(1.f + __expf(-wp)));
            const float av = __builtin_amdgcn_rcpf(1.f + __expf(-(a0c + bf2f(R.lwa[tt] >> 16))));
            float kk = xk * kkc;
            const float n2 = wave_sum_fast(kk * kk);
            kk = kk * rsqrtf(fmaxf(n2, 1e-24f));
            const float kp = xk * (1.f + (av - 1.f) * kac);
            cb[(0 * 16 + t) * 64 + lane] = w; cb[(1 * 16 + t) * 64 + lane] = kk; cb[(2 * 16 + t) * 64 + lane] = kk * av; cb[(3 * 16 + t) * 64 + lane] = kp;
            cb[(4 * 16 + t) * 64 + lane] = xr; cb[(5 * 16 + t) * 64 + lane] = xv; cb[(6 * 16 + t) * 64 + lane] = bf2f(R.lg[tt]);
        }
    };
    rawload(c0); prep(c0, 0);
    __syncthreads();
    LAS float* Y = (LAS float*)(hl + SC_Y);
    for (int ci = 0; ci < nch; ++ci) {
        const int b = ci & 1, c = c0 + ci;
        if (ci + 1 < nch) rawload(c + 1);
        const LAS float* cb = (const LAS float*)(hl + b * SC_CHB);
#pragma unroll 8
        for (int t = 0; t < 16; ++t) {
            const LAS float* p = cb + t * 64 + 8 * ks;
            const V8 w = ld8(p), kk = ld8(p + 1024), bb = ld8(p + 2048), kv = ld8(p + 3072);
            const float va = cb[(5 * 16 + t) * 64 + vr0], vb = cb[(5 * 16 + t) * 64 + vr1];
            float da = dot8(Sa, kk), db = dot8(Sb, kk);
            da = red8(da); db = red8(db);
            upd8(Sa, w, bb, kv, -da, va); upd8(Sb, w, bb, kv, -db, vb);
            if (MODE == 1) {
                float pa = dot8(Pa, kk), pb = dot8(Pb, kk);
                pa = red8(pa); pb = red8(pb);
                updp8(Pa, w, bb, -pa); updp8(Pb, w, bb, -pb);
            } else {
                const V8 rr = ld8(p + 4096);
                float ya = dot8(Sa, rr), yb = dot8(Sb, rr);
                ya = red8(ya); yb = red8(yb);
                if (ks == 0) { Y[t * 64 + vr0] = ya; Y[t * 64 + vr1] = yb; }
            }
        }
        __syncthreads();
        if (MODE == 0) {
#pragma unroll
            for (int tt = 0; tt < 4; ++tt) {
                const int t = 4 * hw + tt; const size_t m = (size_t)rowbase + 16 * c + t;
                const float y = Y[t * 64 + lane];
                const float mean = wave_sum_fast(y) * (1.f / 64.f); const float dv = y - mean;
                const float var = wave_sum_fast(dv * dv) * (1.f / 64.f);
                const float yn = dv * rsqrtf(var + 64e-5f) * lng + lnb;
                const float r = cb[(4 * 16 + t) * 64 + lane], kp = cb[(3 * 16 + t) * 64 + lane], v = cb[(5 * 16 + t) * 64 + lane], g = cb[(6 * 16 + t) * 64 + lane];
                const float rk = wave_sum_fast(r * kp * rkc);
                MIX[m * DM + 512 + c_] = (bf16_t)f2bf((yn + rk * v) * g);
            }
        }
        if (ci + 1 < nch) prep(c + 1, b ^ 1);
        __syncthreads();
    }
    if (u.Sout) {
        float* so = u.Sout + (size_t)vr0 * 64 + 8 * ks;
        *(f32x4*)so = (f32x4){Sa.p[0].x, Sa.p[0].y, Sa.p[1].x, Sa.p[1].y}; *(f32x4*)(so + 4) = (f32x4){Sa.p[2].x, Sa.p[2].y, Sa.p[3].x, Sa.p[3].y};
        *(f32x4*)(so + 512) = (f32x4){Sb.p[0].x, Sb.p[0].y, Sb.p[1].x, Sb.p[1].y}; *(f32x4*)(so + 516) = (f32x4){Sb.p[2].x, Sb.p[2].y, Sb.p[3].x, Sb.p[3].y};
    }
    if (MODE == 1) {
        float* po = u.Pout + (size_t)vr0 * 64 + 8 * ks;
        *(f32x4*)po = (f32x4){Pa.p[0].x, Pa.p[0].y, Pa.p[1].x, Pa.p[1].y}; *(f32x4*)(po + 4) = (f32x4){Pa.p[2].x, Pa.p[2].y, Pa.p[3].x, Pa.p[3].y};
        *(f32x4*)(po + 512) = (f32x4){Pb.p[0].x, Pb.p[0].y, Pb.p[1].x, Pb.p[1].y}; *(f32x4*)(po + 516) = (f32x4){Pb.p[2].x, Pb.p[2].y, Pb.p[3].x, Pb.p[3].y};
    }
}
__device__ __forceinline__ void scan_combine(LAS unsigned char* lds, CArgsP a) {
    if (blockIdx.x >= 64) return;
    const int tid = threadIdx.x, h = blockIdx.x >> 3, rw = tid >> 6, v = (blockIdx.x & 7) * 8 + rw, kq = tid & 63;
    const float* PM = (const float*)(a->ws + WS_PM); const float* UM = (const float*)(a->ws + WS_UM); float* SS = (float*)(a->ws + WS_SS);
    LAS float* Sl = (LAS float*)lds;
    LAS float* Pl = (LAS float*)(lds + 4096);
    constexpr int GL = NSEG - 2;
    float cur = SS[((size_t)(1 * 8 + h) * 64 + v) * 64 + kq];
    f32x4 pa, pb;
    float u1, u2;
    {
        const f32x4* P1 = (const f32x4*)(PM + (size_t)(1 * 8 + h) * 4096);
        *(LAS f32x4*)(Pl + 1 * 4096 + 4 * tid) = P1[tid]; *(LAS f32x4*)(Pl + 1 * 4096 + 2048 + 4 * tid) = P1[512 + tid];
        if (GL >= 2) { const f32x4* P2 = (const f32x4*)(PM + (size_t)(2 * 8 + h) * 4096);
            *(LAS f32x4*)(Pl + 2 * 4096 + 4 * tid) = P2[tid]; *(LAS f32x4*)(Pl + 2 * 4096 + 2048 + 4 * tid) = P2[512 + tid]; }
        u1 = UM[((size_t)(1 * 8 + h) * 64 + v) * 64 + kq];
        u2 = GL >= 2 ? UM[((size_t)(2 * 8 + h) * 64 + v) * 64 + kq] : 0.f;
    }
    for (int g = 1; g <= GL; ++g) {
        const bool pf = (g + 2 <= GL);
        float u3 = 0.f;
        if (pf) { const f32x4* Pn = (const f32x4*)(PM + (size_t)((g + 2) * 8 + h) * 4096); pa = Pn[tid]; pb = Pn[512 + tid]; u3 = UM[((size_t)((g + 2) * 8 + h) * 64 + v) * 64 + kq]; }
        asm volatile("s_waitcnt lgkmcnt(0)\n\ts_barrier" ::: "memory");
        const LAS float* Pg = Pl + (g % 3) * 4096 + kq;
        float acc0 = u1, acc1 = 0.f, acc2 = 0.f, acc3 = 0.f;
        const int curi = __builtin_bit_cast(int, cur);
#pragma unroll
        for (int k = 0; k < 64; k += 4) {
            const float s0 = __builtin_bit_cast(float, __builtin_amdgcn_readlane(curi, k)), s1 = __builtin_bit_cast(float, __builtin_amdgcn_readlane(curi, k + 1));
            const float s2 = __builtin_bit_cast(float, __builtin_amdgcn_readlane(curi, k + 2)), s3 = __builtin_bit_cast(float, __builtin_amdgcn_readlane(curi, k + 3));
            acc0 += s0 * Pg[(k + 0) * 64]; acc1 += s1 * Pg[(k + 1) * 64]; acc2 += s2 * Pg[(k + 2) * 64]; acc3 += s3 * Pg[(k + 3) * 64];
        }
        cur = (acc0 + acc1) + (acc2 + acc3);
        SS[((size_t)((g + 1) * 8 + h) * 64 + v) * 64 + kq] = cur;
        if (pf) { LAS float* dst = Pl + ((g + 2) % 3) * 4096; *(LAS f32x4*)(dst + 4 * tid) = pa; *(LAS f32x4*)(dst + 2048 + 4 * tid) = pb; }
        u1 = u2; u2 = u3;
    }
}

constexpr size_t WS_BAR = 512 * 1024, BAR_BYTES = 16 * 1024;
constexpr int LDS_MISC = 131072 + 64;
#define XB_TMO      128
#define XB_XCNT(j)  (256  + 64 * (j))
#define XB_XSUB(j)  (1280 + 64 * (j))
#define XB_XGEN(j)  (2304 + 64 * (j))
#define XB_TOP      3328
#define XB_TOPGEN   3392
#define XCD_BAR_WORDS 3456
#define XB_SPIN_CAP (1u << 18)

__device__ __forceinline__ unsigned xb_ld(unsigned* p)              { return __hip_atomic_load(p, __ATOMIC_RELAXED, __HIP_MEMORY_SCOPE_AGENT); }
__device__ __forceinline__ unsigned xb_add(unsigned* p, unsigned v) { return __hip_atomic_fetch_add(p, v, __ATOMIC_RELAXED, __HIP_MEMORY_SCOPE_AGENT); }
__device__ __forceinline__ unsigned xb_xcc_id() { return (unsigned)__builtin_amdgcn_s_getreg((3 << 11) | 20) & 0xFu; }
#define XB_SPIN(cond, bar) do { unsigned _sp = 0; while (cond) { __builtin_amdgcn_s_sleep(1); \
    if ((++_sp & 255u) == 0u) { if (xb_ld(&(bar)[XB_TMO])) break; if (_sp > XB_SPIN_CAP) { atomicAdd(&(bar)[XB_TMO], 1u); break; } } } } while (0)

struct XcdBarrier {
    unsigned* bar; unsigned x;
    volatile LAS unsigned* st;
};

__device__ __forceinline__ XcdBarrier xcd_barrier_post(unsigned* bar, volatile LAS unsigned* st) {
    XcdBarrier b; b.bar = bar; b.x = xb_xcc_id(); b.st = st;
    if (threadIdx.x == 0) (void)xb_add(&bar[XB_XCNT(b.x)], 1u);
    return b;
}
__device__ __forceinline__ void xcd_barrier_complete(unsigned* bar, unsigned x, unsigned& nloc, unsigned& nx) {
    const unsigned G = gridDim.x * gridDim.y * gridDim.z;
    unsigned sum, cnt, mine, sp = 0u;
    for (;;) {
        sum = 0u; cnt = 0u; mine = 0u;
#pragma unroll
        for (unsigned j = 0; j < 16; ++j) { const unsigned c = xb_ld(&bar[XB_XCNT(j)]); sum += c; cnt += (c > 0u) ? 1u : 0u; mine = (j == x) ? c : mine; }
        if (sum == G) break;
        __builtin_amdgcn_s_sleep(1);
        if ((++sp & 255u) == 0u) { if (xb_ld(&bar[XB_TMO])) break; if (sp > XB_SPIN_CAP) { atomicAdd(&bar[XB_TMO], 1u); break; } }
    }
    nloc = mine > 0u ? mine : 1u; nx = cnt > 0u ? cnt : 1u;
}

__device__ __forceinline__ void xcd_barrier(const XcdBarrier& b) {
    asm volatile("s_waitcnt vmcnt(0)" ::: "memory");
    __syncthreads();
    if (threadIdx.x == 0) {
        unsigned* bar = b.bar;
        __builtin_amdgcn_s_waitcnt(0);
        unsigned nloc = b.st[0], nx = b.st[1];
        if (nloc == 0u) { xcd_barrier_complete(bar, b.x, nloc, nx); b.st[0] = nloc; b.st[1] = nx; }
        const unsigned old = xb_add(&bar[XB_XSUB(b.x)], 1u);
        const unsigned gen = old / nloc;
        if (old + 1u == (gen + 1u) * nloc) {
            __builtin_amdgcn_fence(__ATOMIC_RELEASE, "agent");
            asm volatile("s_waitcnt vmcnt(0)" ::: "memory");
            const unsigned og = xb_add(&bar[XB_TOP], 1u);
            const unsigned tg = og / nx;
            if (og + 1u == (tg + 1u) * nx) xb_add(&bar[XB_TOPGEN], 1u);
            else XB_SPIN(xb_ld(&bar[XB_TOPGEN]) == tg, bar);
            __builtin_amdgcn_fence(__ATOMIC_ACQUIRE, "agent");
            xb_add(&bar[XB_XGEN(b.x)], 1u);
            asm volatile("s_waitcnt vmcnt(0)" ::: "memory");
        } else {
            XB_SPIN(xb_ld(&bar[XB_XGEN(b.x)]) == gen, bar);
            __builtin_amdgcn_fence(__ATOMIC_ACQUIRE, "agent");
            asm volatile("s_waitcnt vmcnt(0)" ::: "memory");
        }
    }
    __syncthreads();
}

__device__ __forceinline__ void grid_bar(LAS unsigned char* lds) {
    CArgsP a = get_args(); XcdBarrier b; b.bar = (unsigned*)(a->ws + WS_BAR); b.x = xb_xcc_id(); b.st = (volatile LAS unsigned*)(lds + LDS_MISC);
    xcd_barrier(b);
}

constexpr int CNT_FFN1 = 3840, CNT_FFN2 = 3904;
struct SampleFirstOrder {
    int nM, nN, nwg, G, c, nS; unsigned* cnt;
    __device__ void init(int M, int N, int G_, int c_, unsigned* cnt_) { nM = M / 256; nN = N / 256; nwg = nM * nN; G = G_; c = c_; nS = nN; cnt = cnt_; }
    __device__ bool next(int i, pg8::Unit& u) const {
        long L = (long)i * G + c;
        if (G == 256 && nN == 22) {
            if (c >= G - 4) { if (i >= 3) return false; }
            else if (c >= G - 12 && i == 5) { const int k = c - (G - 12); L = (long)(3 + (k >> 2)) * G + (G - 4 + (k & 3)); }
        }
        if (L < nS) { u.pm = nM; u.pn = (int)L; return true; }
        L -= nS; if (L >= nwg) return false;
        int wgid = (int)L; { const int q = nwg / pg8::NXCD, r = nwg % pg8::NXCD, xcd = wgid % pg8::NXCD, off = wgid / pg8::NXCD; wgid = (xcd < r ? xcd * (q + 1) : r * (q + 1) + (xcd - r) * q) + off; }
        const int nig = pg8::WGM * nN, gid = wgid / nig, fm = gid * pg8::WGM, gsz = (nM - fm) < pg8::WGM ? (nM - fm) : pg8::WGM;
        u.pm = fm + ((wgid % nig) % gsz); u.pn = (wgid % nig) / gsz; return true;
    }
    __device__ __forceinline__ void a_ready(const pg8::Unit&) const {}
    __device__ __forceinline__ void done(const pg8::Unit& u) const {
        if (u.pm == nM) { __builtin_amdgcn_fence(__ATOMIC_RELEASE, "agent"); if ((threadIdx.x & 63) == 0) __hip_atomic_fetch_add(cnt, 1u, __ATOMIC_RELAXED, __HIP_MEMORY_SCOPE_AGENT); }
    }
};
struct OneUnit {
    int pm, pn;
    __device__ bool next(int i, pg8::Unit& u) const { if (i) return false; u.pm = pm; u.pn = pn; return true; }
    __device__ __forceinline__ void a_ready(const pg8::Unit&) const {}
    __device__ __forceinline__ void done(const pg8::Unit&) const {}
};
__device__ __forceinline__ void wait_count(unsigned* cnt, unsigned want) {
    if (threadIdx.x == 0) {
        unsigned sp = 0;
        while (__hip_atomic_load(cnt, __ATOMIC_RELAXED, __HIP_MEMORY_SCOPE_AGENT) < want && ++sp < (1u << 24)) __builtin_amdgcn_s_sleep(2);
        __builtin_amdgcn_fence(__ATOMIC_ACQUIRE, "agent");
        asm volatile("s_waitcnt vmcnt(0)" ::: "memory");
    }
    __syncthreads();
}

#ifdef PROBE_PHASE
__device__ __forceinline__ int probe_reps(int k) { int n = (k == PROBE_PHASE) ? 2 : 1; asm volatile("" : "+s"(n)); return n; }
#define PH(k) for (int r_ = 0, n_ = probe_reps(k); r_ < n_; ++r_)
#else
#define PH(k)
#endif
constexpr int LDS_BYTES = 136 * 1024;
__global__ void __launch_bounds__(512, 2) mega_fwd(Args a_unused) {
    extern __shared__ __attribute__((aligned(16))) unsigned char lds_raw[];
    cg::grid_group grid = cg::this_grid();
    LAS unsigned char* lds = (LAS unsigned char*)lds_raw;
    const int tid = threadIdx.x, lane = tid & 63, wave = __builtin_amdgcn_readfirstlane(tid >> 6);
    const int G = gridDim.x, bx = blockIdx.x;
    if (tid < 64) ((LAS unsigned*)(lds + 131072))[tid] = 0u;
    __syncthreads();

    { CArgsP a = get_args(); phase0(a, lds, wave, lane);
      if (bx == 0) { unsigned* bw = (unsigned*)(a->ws + WS_BAR); for (int i = tid; i < (int)(BAR_BYTES / 4); i += 512) bw[i] = 0u; } }
    grid.sync();
    { CArgsP a = get_args(); (void)xcd_barrier_post((unsigned*)(a->ws + WS_BAR), (volatile LAS unsigned*)(lds + LDS_MISC)); }
    PH(1) { CArgsP a = get_args(); unsigned char* ws = a->ws; unsigned* cnt = (unsigned*)(ws + WS_BAR) + CNT_FFN1;
      { pg8::Gemm g{(const bf16_t*)(ws + WS_XB), (const bf16_t*)(ws + WS_W1I), MROWS, 2 * DFF, DM}; SampleFirstOrder S; S.init(TP, 2 * DFF, G, bx, cnt);
        EpiSwiglu E{(bf16_t*)(ws + WS_H), (const float*)(ws + WS_ROWSQ0)}; pg8::gemm_phase<EpiSwiglu, SampleFirstOrder, true, true>(lds, g, S, E); }
      if (bx >= G - 4) {
        wait_count(cnt, 8u * (2 * DFF / 256));
        pg8::Gemm g{(const bf16_t*)(ws + WS_H), (const bf16_t*)(ws + WS_W1O), MROWS, DM, DFF}; OneUnit S{TP / 256, bx - (G - 4)};
        EpiResid E{a->in[0], a->in[1], a->out, (bf16_t*)(ws + WS_XB), (float*)(ws + WS_ROWSQ1), 0.5f, 0}; pg8::gemm_phase<EpiResid, OneUnit, true, true>(lds, g, S, E); } }
    grid_bar(lds);
    PH(2) { CArgsP a = get_args(); unsigned char* ws = a->ws;
      pg8::Gemm g{(const bf16_t*)(ws + WS_H), (const bf16_t*)(ws + WS_W1O), TP, DM, DFF}; pg8::StaticOrder S; S.init(TP, DM, G, bx);
      EpiResid E{a->in[0], a->in[1], a->out, (bf16_t*)(ws + WS_XB), (float*)(ws + WS_ROWSQ1), 0.5f, 0}; pg8::gemm_phase<EpiResid, pg8::StaticOrder, true, true>(lds, g, S, E); }
    grid_bar(lds);
    PH(3) { CArgsP a = get_args(); unsigned char* ws = a->ws;
      pg8::Gemm g{(const bf16_t*)(ws + WS_XB), (const bf16_t*)(ws + WS_WIN), MROWS, NPROJ, DM}; pg8::StaticOrder S; S.init(MROWS, NPROJ, G, bx);
      EpiProj E{(const float*)(ws + WS_ROWSQ1), ws, a->out, a->in[14], a->in[15], a->in[13]};
      pg8::gemm_phase<EpiProj, pg8::StaticOrder, true, true>(lds, g, S, E); }
    grid_bar(lds);
    PH(4) { CArgsP a = get_args(); phase4(a, wave, lane); }
    grid_bar(lds);
    { CArgsP a = get_args(); cum_fixup(a); }
    PH(5) { CArgsP a = get_args(); unsigned char* ws = a->ws;

      int kl = KLORA; asm volatile("" : "+s"(kl));
      pg8::Gemm g{(const bf16_t*)(ws + WS_LORAA), (const bf16_t*)(ws + WS_WLORA), MROWS, NLORA, kl}; pg8::StaticOrder S; S.init(MROWS, NLORA, G, bx);
      EpiBf16N E{(bf16_t*)(ws + WS_LORA), NLORA}; pg8::gemm_phase<EpiBf16N, pg8::StaticOrder, true, true>(lds, g, S, E);
      if (G == 256 && bx >= 134) convert_weights(a, lds, wave, lane, 1, bx - 134, 122); }
    grid_bar(lds);
    PH(6) {
        CArgsP a = get_args();
        float gqm = 0.f, gkm = 0.f;
        { const float gq = fabsf(a->in[14][lane]), gk = fabsf(a->in[15][lane]); gqm = wave_max(gq); gkm = wave_max(gk); }
        const float thr = 30.f + 16.f * gqm * gkm;
        float* SS = (float*)(a->ws + WS_SS); float* PM = (float*)(a->ws + WS_PM); float* UM = (float*)(a->ws + WS_UM);
        const int half = tid >> 8;
        constexpr int NUPP = 4 * (NSEG - 2), NSC = 4 + NUPP;
        PH(10) for (int it = bx; it < NSC; it += G) {
            if (it < 4) { const int hh = 2 * it + half; ScanUnit u{0, hh, 0, nullptr, SS + (size_t)(1 * 8 + hh) * 4096, nullptr}; scan_pair<0>(lds, a, u, SEGCH); }
            else { const int uu = 2 * (it - 4) + half, g = 1 + (uu >> 3), hh = uu & 7;
                ScanUnit u{0, hh, g * SEGCH, nullptr, UM + (size_t)(g * 8 + hh) * 4096, PM + (size_t)(g * 8 + hh) * 4096}; scan_pair<1>(lds, a, u, SEGCH); }
        }
        if (G == 256) {
            int a0, an;
            if (bx >= 252) { a0 = 500 + 3 * (bx - 252); an = 3; } else if (bx >= 4) { a0 = 2 * (bx - 4); an = 2; } else { a0 = 496 + bx; an = 1; }
            PH(11) for (int it = a0; it < a0 + an; ++it) attn_unit(lds, a, it & 7, 63 - (it >> 3), thr);
        } else {
            for (int it = (bx + G - NSC % G) % G; it < 512; it += G) attn_unit(lds, a, it & 7, 63 - (it >> 3), thr);
        }
        if (G != 256) for (int it = G - 1 - bx; it < 128; it += G) attn_sample_unit(lds, a, it >> 3, it & 7);
        if (G != 256) for (int it = ((G - 129 - bx) % G + G) % G; it < 64; it += G) {
            const int uu = 2 * it + half, sb = uu >> 3, hh = uu & 7;
            ScanUnit u{1 + sb, hh, 0, a->in[5] + (size_t)(sb * 8 + hh) * 4096, a->out + OFF_STS + (size_t)(sb * 8 + hh) * 4096, nullptr}; scan_pair<0>(lds, a, u, 1);
        }
    }
    grid_bar(lds);
    PH(7) { CArgsP a = get_args(); if (bx < 64 || G <= 64) scan_combine(lds, a); __syncthreads(); if (G != 256 && (bx >= 64 || G <= 64)) convert_weights(a, lds, wave, lane, 1, G <= 64 ? bx : bx - 64, G <= 64 ? G : G - 64); if (G == 256 && bx >= 64 && bx < 192) attn_sample_unit(lds, a, (bx - 64) >> 3, (bx - 64) & 7);
      if (G == 256 && bx >= 192) {
          const int uu = 2 * (bx - 192) + (tid >> 8), sb = uu >> 3, hh = uu & 7;
          ScanUnit u{1 + sb, hh, 0, a->in[5] + (size_t)(sb * 8 + hh) * 4096, a->out + OFF_STS + (size_t)(sb * 8 + hh) * 4096, nullptr}; scan_pair<0>(lds, a, u, 1);
      } }
    grid_bar(lds);
    PH(8) { CArgsP a = get_args();
      float* SS = (float*)(a->ws + WS_SS);
      const int half = tid >> 8;
      PH(14) for (int it = bx; it < 4 * (NSEG - 1); it += G) {
          const int uu = 2 * it + half, g = 1 + (uu >> 3), hh = uu & 7;
          ScanUnit u{0, hh, g * SEGCH, SS + (size_t)(g * 8 + hh) * 4096, g == NSEG - 1 ? a->out + OFF_STP + (size_t)hh * 4096 : nullptr, nullptr};
          scan_pair<0>(lds, a, u, SEGCH);
      }
      if (bx >= G - 4) {
        unsigned char* ws = a->ws;
        pg8::Gemm g{(const bf16_t*)(ws + WS_XB), (const bf16_t*)(ws + WS_WOUT), MROWS, DM, DM}; OneUnit S{TP / 256, bx - (G - 4)};
        EpiResid E{nullptr, nullptr, a->out, (bf16_t*)(ws + WS_X2B), (float*)(ws + WS_ROWSQ2), 1.0f, 1}; pg8::gemm_phase<EpiResid, OneUnit, true, true>(lds, g, S, E); }
    }
    grid_bar(lds);
    { CArgsP a = get_args(); unsigned char* ws = a->ws;
      pg8::Gemm g{(const bf16_t*)(ws + WS_XB), (const bf16_t*)(ws + WS_WOUT), TP, DM, DM}; pg8::StaticOrder S; S.init(TP, DM, G, bx);
      EpiResid E{nullptr, nullptr, a->out, (bf16_t*)(ws + WS_X2B), (float*)(ws + WS_ROWSQ2), 1.0f, 1}; pg8::gemm_phase<EpiResid, pg8::StaticOrder, true, true>(lds, g, S, E); }
    grid_bar(lds);
    PH(9) { CArgsP a = get_args(); unsigned char* ws = a->ws; unsigned* cnt = (unsigned*)(ws + WS_BAR) + CNT_FFN2;
      { pg8::Gemm g{(const bf16_t*)(ws + WS_X2B), (const bf16_t*)(ws + WS_W2I), MROWS, 2 * DFF, DM}; SampleFirstOrder S; S.init(TP, 2 * DFF, G, bx, cnt);
        EpiSwiglu E{(bf16_t*)(ws + WS_H), (const float*)(ws + WS_ROWSQ2)}; pg8::gemm_phase<EpiSwiglu, SampleFirstOrder, true, true>(lds, g, S, E); }
      if (bx >= G - 4) {
        wait_count(cnt, 8u * (2 * DFF / 256));
        pg8::Gemm g{(const bf16_t*)(ws + WS_H), (const bf16_t*)(ws + WS_W2O), MROWS, DM, DFF}; OneUnit S{TP / 256, bx - (G - 4)};
        EpiResid E{nullptr, nullptr, a->out, nullptr, nullptr, 0.5f, 1}; pg8::gemm_phase<EpiResid, OneUnit, true, true>(lds, g, S, E); } }
    grid_bar(lds);
    { CArgsP a = get_args(); unsigned char* ws = a->ws;
      pg8::Gemm g{(const bf16_t*)(ws + WS_H), (const bf16_t*)(ws + WS_W2O), TP, DM, DFF}; pg8::StaticOrder S; S.init(TP, DM, G, bx);
      EpiResid E{nullptr, nullptr, a->out, nullptr, nullptr, 0.5f, 1}; pg8::gemm_phase<EpiResid, pg8::StaticOrder, true, true>(lds, g, S, E); }
}

extern "C" void kernel_launch(void* const* d_in, const int* in_sizes, int n_in, void* d_out, int out_size, void* d_ws, size_t ws_size, hipStream_t stream) {
    static int grid = 0;
    if (grid == 0) {
        if (n_in != 30 || out_size != (int)OUT_TOTAL || ws_size < WS_END || in_sizes[0] != TP * DM) { fprintf(stderr, "kernel_launch: unexpected shapes (n_in %d out %d ws %zu)\n", n_in, out_size, ws_size); grid = -1; return; }
        int dev = 0, cus = 0, per_cu = 0;
        if (hipGetDevice(&dev) != hipSuccess || hipDeviceGetAttribute(&cus, hipDeviceAttributeMultiprocessorCount, dev) != hipSuccess) { grid = -1; return; }
        if (hipFuncSetAttribute((const void*)mega_fwd, hipFuncAttributeMaxDynamicSharedMemorySize, LDS_BYTES) != hipSuccess) { fprintf(stderr, "kernel_launch: hipFuncSetAttribute failed\n"); grid = -1; return; }
        if (hipOccupancyMaxActiveBlocksPerMultiprocessor(&per_cu, (const void*)mega_fwd, 512, LDS_BYTES) != hipSuccess || per_cu < 1) { fprintf(stderr, "kernel_launch: occupancy query failed (%d)\n", per_cu); (void)hipGetLastError(); grid = -1; return; }
        grid = cus * per_cu;
    }
    if (grid < 64) return;
    Args a{};
    for (int i = 0; i < 30; ++i) a.in[i] = (const float*)d_in[i];
    a.out = (float*)d_out; a.ws = (unsigned char*)d_ws;
    void* args[] = {&a};
    hipError_t e = hipLaunchCooperativeKernel((const void*)mega_fwd, dim3(grid), dim3(512), args, LDS_BYTES, stream);
    if (e != hipSuccess) fprintf(stderr, "kernel_launch: cooperative launch failed: %s (grid %d)\n", hipGetErrorString(e), grid);
}
```

```cpp
#include <hip/hip_runtime.h>
#include <hip/hip_cooperative_groups.h>
#include <cstdio>
#include <cstdint>
namespace cg = cooperative_groups;
namespace pg8 {
#define PG8_LAS __attribute__((address_space(3)))
typedef unsigned short bf16_t;
typedef short bf16x8 __attribute__((ext_vector_type(8)));
typedef float f32x4 __attribute__((ext_vector_type(4)));
typedef unsigned u32x4 __attribute__((ext_vector_type(4)));
constexpr int BM = 256, BK = 64, HALF = 128, HTB = HALF * BK * 2  , STAGE_BYTES = 8 * HTB, NXCD = 8, WGM = 8;

__host__ __device__ __forceinline__ int lds_byte(int r, int c) { const int st = (r >> 4) * 2 + (c >> 5), rr = r & 15, cc = c & 31, ob = rr * 64 + cc * 2; return st * 1024 + (ob ^ (((ob >> 9) & 1) << 5)); }
__host__ __device__ __forceinline__ void stage_rc(int b, int& R, int& C) { const int st = b / 1024, sb = b % 1024, swz = sb ^ (((sb >> 9) & 1) << 5); R = (st >> 1) * 16 + swz / 64; C = (st & 1) * 32 + (swz % 64) / 2; }
__host__ __device__ __forceinline__ int perm32(int rho) { const int n = rho >> 4, i = rho & 15; return 8 * (i >> 2) + 4 * n + (i & 3); }

struct Unit { int pm, pn; };
struct Gemm { const bf16_t* A; const bf16_t* Bt; int M, N, K; };

struct StaticOrder {
    int nM, nN, nwg, G, c;
    __host__ __device__ void init(int M, int N, int G_, int c_) { nM = M / BM; nN = N / BM; nwg = nM * nN; G = G_; c = c_; }
    __host__ __device__ bool next(int i, Unit& u) const {
        const long L = (long)i * G + c; if (L >= nwg) return false;
        int wgid = (int)L; { const int q = nwg / NXCD, r = nwg % NXCD, xcd = wgid % NXCD, off = wgid / NXCD; wgid = (xcd < r ? xcd * (q + 1) : r * (q + 1) + (xcd - r) * q) + off; }
        const int nig = WGM * nN, gid = wgid / nig, fm = gid * WGM, gsz = (nM - fm) < WGM ? (nM - fm) : WGM;
        u.pm = fm + ((wgid % nig) % gsz); u.pn = (wgid % nig) / gsz; return true;
    }
    __device__ __forceinline__ void a_ready(const Unit&) const {}
    __device__ __forceinline__ void done(const Unit&) const {}
};

__device__ __forceinline__ unsigned cvt_pk_bf16(float lo, float hi) { unsigned r; asm volatile("v_cvt_pk_bf16_f32 %0, %1, %2" : "=v"(r) : "v"(lo), "v"(hi)); return r; }
template <class Epi, class Sched, bool ALIGN_EPI = false, bool SP2 = false>
__device__ __forceinline__ void gemm_phase(PG8_LAS unsigned char* lds, const Gemm g, const Sched& S, const Epi& E) {
    int tid_l = threadIdx.x; asm volatile("" : "+v"(tid_l));
    const int tid = tid_l, wid = __builtin_amdgcn_readfirstlane(tid >> 6), lane = tid & 63, wr = wid >> 2, wc = wid & 3, fr = lane & 15, fq = lane >> 4;
    const int K = g.K, nt = K / BK;
    unsigned voffA[2], voffB[2];
#pragma unroll
    for (int i = 0; i < 2; ++i) { int R, C; stage_rc(tid * 16 + i * 8192, R, C); const int Rb = Epi::PERM ? ((R & ~31) + perm32(R & 31)) : R;
        voffA[i] = (unsigned)(R * K + C) * 2u; voffB[i] = (unsigned)(Rb * K + C) * 2u; }
    const size_t kstep = (size_t)(BK * 2);
    const size_t hstep = (size_t)HALF * K * 2;
    const size_t tstep = 2 * hstep;
    const unsigned ldsw = (unsigned)wid * 1024u;
    const int aoff = lds_byte(wr * 64 + fr, fq * 8), boff = lds_byte(wc * 32 + fr, fq * 8);
#define PG8_SA(b, h) (((b) * 2 + (h)) * HTB)
#define PG8_SB(b, h) ((4 + (b) * 2 + (h)) * HTB)
#define PG8_STAGE(bufoff, gbase, voff) do { _Pragma("unroll") for (int _i = 0; _i < 2; ++_i) \
        __builtin_amdgcn_global_load_lds((const unsigned*)((const char*)(gbase) + (voff)[_i]), (PG8_LAS unsigned*)(lds + (bufoff) + ldsw + _i * 8192), 16, 0, 0); } while (0)
#define PG8_LDA(dst, b, h) do { _Pragma("unroll") for (int m = 0; m < 4; ++m) _Pragma("unroll") for (int k = 0; k < 2; ++k) dst[m][k] = *(const PG8_LAS bf16x8*)(lds + PG8_SA(b, h) + aoff + m * 2048 + k * 1024); } while (0)
#define PG8_LDB(dst, b, h) do { _Pragma("unroll") for (int n = 0; n < 2; ++n) _Pragma("unroll") for (int k = 0; k < 2; ++k) dst[n][k] = *(const PG8_LAS bf16x8*)(lds + PG8_SB(b, h) + boff + n * 2048 + k * 1024); } while (0)
#define PG8_MMA(ai, bj, At, Bt) do { __builtin_amdgcn_s_setprio(1); _Pragma("unroll") for (int m = 0; m < 4; ++m) _Pragma("unroll") for (int n = 0; n < 2; ++n) _Pragma("unroll") for (int k = 0; k < 2; ++k) \
        acc[ai][bj][m][n] = __builtin_amdgcn_mfma_f32_16x16x32_bf16(Bt[n][k], At[m][k], acc[ai][bj][m][n], 0, 0, 0); __builtin_amdgcn_s_setprio(0); } while (0)
#define PG8_WAIT_V(n) asm volatile("s_waitcnt vmcnt(" #n ")" ::: "memory")
#define PG8_WAIT_L(n) asm volatile("s_waitcnt lgkmcnt(" #n ")" ::: "memory")
#define PG8_BAR __builtin_amdgcn_s_barrier()
#define PG8_SCHED __builtin_amdgcn_sched_barrier(0)
    Unit cur, nxt; int ui = 0;
    if (!S.next(0, cur)) return;
    f32x4 acc[2][2][4][2];
#pragma unroll
    for (int a = 0; a < 2; ++a)
#pragma unroll
        for (int b = 0; b < 2; ++b)
#pragma unroll
            for (int m = 0; m < 4; ++m)
#pragma unroll
                for (int n = 0; n < 2; ++n) acc[a][b][m][n] = (f32x4){0.f, 0.f, 0.f, 0.f};
    bf16x8 At[4][2], B0[2][2], B1[2][2];
    const char* cA = (const char*)g.A + (size_t)cur.pm * tstep; const char* cB = (const char*)g.Bt + (size_t)cur.pn * tstep;
    S.a_ready(cur);
    if constexpr (SP2) {
        PG8_STAGE(PG8_SB(0, 0), cB, voffB); PG8_STAGE(PG8_SB(0, 1), cB + hstep, voffB); PG8_STAGE(PG8_SA(0, 0), cA, voffA); PG8_STAGE(PG8_SA(0, 1), cA + hstep, voffA);
        if (wr == 1) PG8_BAR;
        PG8_WAIT_V(2); PG8_BAR;
        PG8_STAGE(PG8_SB(1, 0), cB + kstep, voffB); PG8_STAGE(PG8_SA(1, 0), cA + kstep, voffA); PG8_STAGE(PG8_SB(1, 1), cB + hstep + kstep, voffB);
        PG8_WAIT_V(6); PG8_BAR;
    } else {
        PG8_STAGE(PG8_SB(0, 0), cB, voffB); PG8_STAGE(PG8_SA(0, 0), cA, voffA); PG8_STAGE(PG8_SB(0, 1), cB + hstep, voffB); PG8_STAGE(PG8_SA(0, 1), cA + hstep, voffA);
        if (wr == 1) PG8_BAR;
        PG8_WAIT_V(4); PG8_BAR;
        PG8_STAGE(PG8_SB(1, 0), cB + kstep, voffB); PG8_STAGE(PG8_SA(1, 0), cA + kstep, voffA); PG8_STAGE(PG8_SB(1, 1), cB + hstep + kstep, voffB);
        PG8_WAIT_V(6); PG8_BAR;
    }
    for (;;) {
        const bool has_next = S.next(ui + 1, nxt);
        const char* nA = has_next ? (const char*)g.A + (size_t)nxt.pm * tstep : cA; const char* nB = has_next ? (const char*)g.Bt + (size_t)nxt.pn * tstep : cB;
        for (int t = 0; t < nt; t += 2) {
            const bool last = (t == nt - 2);
            const char* a1 = cA + (size_t)(t + 1) * kstep;
            const char* a2 = last ? nA : cA + (size_t)(t + 2) * kstep; const char* b2 = last ? nB : cB + (size_t)(t + 2) * kstep;
            const char* a3 = a2 + kstep; const char* b3 = b2 + kstep;
            if (last && has_next) S.a_ready(nxt);
            if constexpr (SP2) {
            PG8_LDB(B0, 0, 0); PG8_LDB(B1, 0, 1); PG8_SCHED; PG8_LDA(At, 0, 0); PG8_STAGE(PG8_SA(1, 1), a1 + hstep, voffA);
            PG8_WAIT_V(8); PG8_WAIT_L(0); PG8_BAR; PG8_MMA(0, 0, At, B0); PG8_MMA(0, 1, At, B1); PG8_BAR; PG8_SCHED;
            PG8_LDA(At, 0, 1); PG8_STAGE(PG8_SB(0, 0), b2, voffB); PG8_STAGE(PG8_SB(0, 1), b2 + hstep, voffB); PG8_STAGE(PG8_SA(0, 0), a2, voffA);
            PG8_WAIT_V(8); PG8_WAIT_L(0); PG8_BAR; PG8_MMA(1, 0, At, B0); PG8_MMA(1, 1, At, B1); PG8_BAR; PG8_SCHED;
            PG8_LDB(B0, 1, 0); PG8_LDB(B1, 1, 1); PG8_SCHED; PG8_LDA(At, 1, 0); PG8_STAGE(PG8_SA(0, 1), a2 + hstep, voffA);
            PG8_WAIT_V(8); PG8_WAIT_L(0); PG8_BAR; PG8_MMA(0, 0, At, B0); PG8_MMA(0, 1, At, B1); PG8_BAR; PG8_SCHED;
            PG8_LDA(At, 1, 1); PG8_STAGE(PG8_SB(1, 0), b3, voffB); PG8_STAGE(PG8_SB(1, 1), b3 + hstep, voffB); PG8_STAGE(PG8_SA(1, 0), a3, voffA);
            PG8_WAIT_V(8); PG8_WAIT_L(0); PG8_BAR; PG8_MMA(1, 0, At, B0); PG8_MMA(1, 1, At, B1); PG8_BAR; PG8_SCHED;
            } else {
            PG8_LDB(B0, 0, 0); PG8_SCHED; PG8_LDA(At, 0, 0); PG8_STAGE(PG8_SA(1, 1), a1 + hstep, voffA);
            PG8_WAIT_L(8); PG8_BAR; PG8_WAIT_L(0); PG8_MMA(0, 0, At, B0); PG8_BAR; PG8_SCHED;
            PG8_LDB(B1, 0, 1); PG8_STAGE(PG8_SB(0, 0), b2, voffB);
            PG8_BAR; PG8_WAIT_L(0); PG8_MMA(0, 1, At, B1); PG8_BAR;
            PG8_LDA(At, 0, 1); PG8_STAGE(PG8_SA(0, 0), a2, voffA);
            PG8_BAR; PG8_WAIT_L(0); PG8_MMA(1, 0, At, B0); PG8_BAR; PG8_SCHED;
            PG8_STAGE(PG8_SB(0, 1), b2 + hstep, voffB);
            PG8_WAIT_V(6); PG8_BAR; PG8_MMA(1, 1, At, B1); PG8_BAR;
            PG8_LDB(B0, 1, 0); PG8_SCHED; PG8_LDA(At, 1, 0); PG8_STAGE(PG8_SA(0, 1), a2 + hstep, voffA);
            PG8_WAIT_L(8); PG8_BAR; PG8_WAIT_L(0); PG8_MMA(0, 0, At, B0); PG8_BAR; PG8_SCHED;
            PG8_LDB(B1, 1, 1); PG8_STAGE(PG8_SB(1, 0), b3, voffB);
            PG8_BAR; PG8_WAIT_L(0); PG8_MMA(0, 1, At, B1); PG8_BAR;
            PG8_LDA(At, 1, 1); PG8_STAGE(PG8_SA(1, 0), a3, voffA);
            PG8_BAR; PG8_WAIT_L(0); PG8_MMA(1, 0, At, B0); PG8_BAR; PG8_SCHED;
            PG8_STAGE(PG8_SB(1, 1), b3 + hstep, voffB);
            PG8_WAIT_V(6); PG8_BAR; PG8_MMA(1, 1, At, B1); PG8_BAR;
            }
        }
        if constexpr (ALIGN_EPI) { if (wr == 0) PG8_BAR; }
        if constexpr (!Epi::AFTER_DRAIN) { E(acc, cur, wr, wc, fr, fq); S.done(cur); }
        if (!has_next) break;
#pragma unroll
        for (int a = 0; a < 2; ++a)
#pragma unroll
            for (int b = 0; b < 2; ++b)
#pragma unroll
                for (int m = 0; m < 4; ++m)
#pragma unroll
                    for (int n = 0; n < 2; ++n) acc[a][b][m][n] = (f32x4){0.f, 0.f, 0.f, 0.f};
        cur = nxt; cA = nA; cB = nB; ++ui;
        if constexpr (ALIGN_EPI) { if (wr == 1) PG8_BAR; }
    }
    PG8_WAIT_V(0);
    if constexpr (!ALIGN_EPI) { if (wr == 0) PG8_BAR; }
    PG8_BAR;
    if constexpr (Epi::AFTER_DRAIN) { E.fused(acc, cur, wr, wc, fr, fq, lds, wid, lane); S.done(cur); }
#undef PG8_SA
#undef PG8_SB
#undef PG8_STAGE
#undef PG8_LDA
#undef PG8_LDB
#undef PG8_MMA
#undef PG8_WAIT_V
#undef PG8_WAIT_L
#undef PG8_BAR
#undef PG8_SCHED
}
}
#define LAS __attribute__((address_space(3)))
typedef unsigned short bf16_t;
typedef float f32x4 __attribute__((ext_vector_type(4)));
typedef float f32x16 __attribute__((ext_vector_type(16)));
typedef unsigned u32x4 __attribute__((ext_vector_type(4)));
typedef unsigned u32x2 __attribute__((ext_vector_type(2)));
typedef short bf16x8 __attribute__((ext_vector_type(8)));

constexpr int TP = 16384, NSB = 16, TSS = 16, PAST = 1024, MROWS = 16640, DM = 1024, DFF = 2816, NPROJ = 3584, RWP = 1792, NLORA = 1536, KLORA = 256;
constexpr float LOG2E = 1.4426950408889634f;
constexpr float QSCALE = 0.125f * LOG2E;
constexpr size_t OFF_KP = 17039360, OFF_VP = 25427968, OFF_LFP = 33816576, OFF_STP = 33947648, OFF_SHP = 33980416, OFF_KS = 33982208, OFF_VS = 34113280,
                 OFF_LFS = 34244352, OFF_STS = 34246400, OFF_SHS = 34770688, OUT_TOTAL = 34799360;
constexpr size_t MiB = 1u << 20;
constexpr size_t WS_ROWSQ0 = 0, WS_ROWSQ1 = 128 * 1024, WS_ROWSQ2 = 256 * 1024, WS_TT = 384 * 1024;
constexpr size_t WS_LOGF = 1 * MiB, WS_CUM = 2 * MiB;
constexpr size_t WS_W1I = 3 * MiB, WS_W1O = 14 * MiB, WS_WIN = 20 * MiB, WS_WOUT = 27 * MiB, WS_W2I = 29 * MiB, WS_W2O = 40 * MiB, WS_WLORA = 46 * MiB;
constexpr size_t WS_XB = 47 * MiB;
constexpr size_t WS_Q = 80 * MiB, WS_K = 97 * MiB, WS_V = 114 * MiB;
constexpr size_t WS_X2B = 80 * MiB;
constexpr size_t WS_H = 131 * MiB;
constexpr size_t WS_PRW = 131 * MiB, WS_LORAA = 188 * MiB, WS_LORA = 197 * MiB;
constexpr size_t WS_SEG = 246 * MiB, WS_END = 256 * MiB;

struct Args { const float* in[30]; float* out; unsigned char* ws; };
typedef const __attribute__((address_space(4))) Args* CArgsP;
__device__ __forceinline__ CArgsP get_args() { CArgsP p = (CArgsP)__builtin_amdgcn_kernarg_segment_ptr(); asm volatile("" : "+s"(p)); return p; }

#define LDS_WAIT() asm volatile("s_waitcnt lgkmcnt(0)" ::: "memory")
__device__ __forceinline__ unsigned f2bf(float f) { unsigned u = __builtin_bit_cast(unsigned, f); return (u + 0x7fffu + ((u >> 16) & 1u)) >> 16; }
__device__ __forceinline__ unsigned pk2(float lo, float hi) { return f2bf(lo) | (f2bf(hi) << 16); }
__device__ __forceinline__ float bf2f(unsigned b) { return __builtin_bit_cast(float, b << 16); }
__device__ __forceinline__ float wave_sum(float v) {
#pragma unroll
    for (int o = 1; o < 64; o <<= 1) v += __shfl_xor(v, o);
    return v;
}
__device__ __forceinline__ float wave_max(float v) {
#pragma unroll
    for (int o = 1; o < 64; o <<= 1) v = fmaxf(v, __shfl_xor(v, o));
    return v;
}
template <int CTRL> __device__ __forceinline__ float dpp_f(float x) { return __builtin_bit_cast(float, __builtin_amdgcn_mov_dpp(__builtin_bit_cast(int, x), CTRL, 0xf, 0xf, true)); }
__device__ __forceinline__ float allred8(float x) { x += dpp_f<0xB1>(x); x += dpp_f<0x4E>(x); x += dpp_f<0x141>(x); return x; }

__device__ __forceinline__ void p0_item(const float* __restrict__ W, int K, int ldn, int nsrc0, int nvalid, const float* __restrict__ gain, bf16_t* WT, int dstrow0, int k0, LAS float* scr, int lane) {
    const int col = lane & 31;
#pragma unroll
    for (int i = 0; i < 32; ++i) {
        const int kk = 2 * i + (lane >> 5);
        float v = 0.f;
        if (col < nvalid) { v = W[(size_t)(k0 + kk) * ldn + nsrc0 + col]; if (gain) v *= gain[k0 + kk]; }
        scr[kk * 33 + col] = v;
    }
    LDS_WAIT();
    const int c = lane & 7;
#pragma unroll
    for (int j = 0; j < 4; ++j) {
        const int n = (lane >> 3) + 8 * j; const LAS float* s = scr + (8 * c) * 33 + n;
        u32x4 o; o.x = pk2(s[0 * 33], s[1 * 33]); o.y = pk2(s[2 * 33], s[3 * 33]); o.z = pk2(s[4 * 33], s[5 * 33]); o.w = pk2(s[6 * 33], s[7 * 33]);
        *(u32x4*)(WT + (size_t)(dstrow0 + n) * K + k0 + 8 * c) = o;
    }
    LDS_WAIT();
}

__device__ __forceinline__ void convert_tile(const float* __restrict__ W, int K, int ldn, const float* __restrict__ gain, bf16_t* WT, int pn, int k0, int kind, LAS unsigned char* lds, int wave, int lane) {
    LAS float* T = (LAS float*)lds;
    const int c = 4 * lane, q = c >> 5, db = 8 * pn + q;
    int nsrc0, nvalid = 32;
    if (kind == 0) nsrc0 = (q >> 2) * DFF + 128 * pn + 32 * (q & 3);
    else if (kind == 1) nsrc0 = 32 * db;
    else { const int l = 256 * pn + 64 * (q & 3) + 32 * (q >> 2); if (l < 1536) nsrc0 = l; else if (l < 3328) nsrc0 = l + 8; else { nsrc0 = 1536; nvalid = (l == 3328) ? 8 : 0; } }
    const bool ok = (c & 31) < nvalid;
    __syncthreads();
    f32x4 v[8];
#pragma unroll
    for (int i = 0; i < 8; ++i) { const int kk = 8 * wave + i; v[i] = (f32x4){0.f, 0.f, 0.f, 0.f}; if (ok) v[i] = *(const f32x4*)(W + (size_t)(k0 + kk) * ldn + nsrc0 + (c & 31)); }
#pragma unroll
    for (int i = 0; i < 8; ++i) { const int kk = 8 * wave + i; f32x4 t = v[i]; if (gain) t = t * gain[k0 + kk]; *(LAS f32x4*)(T + kk * 260 + c) = t; }
    __syncthreads();
    const int tid = wave * 64 + lane, n = tid & 255, hf = tid >> 8;
    u32x4 o[4];
#pragma unroll
    for (int j = 0; j < 4; ++j) {
        const LAS float* sp = T + (32 * hf + 8 * j) * 260 + n;
        o[j].x = pk2(sp[0 * 260], sp[1 * 260]); o[j].y = pk2(sp[2 * 260], sp[3 * 260]); o[j].z = pk2(sp[4 * 260], sp[5 * 260]); o[j].w = pk2(sp[6 * 260], sp[7 * 260]);
    }
    u32x4* dst = (u32x4*)(WT + (size_t)(256 * pn + n) * K + k0 + 32 * hf);
#pragma unroll
    for (int j = 0; j < 4; ++j) dst[j] = o[j];
}
__device__ __forceinline__ void convert_weights(CArgsP a, LAS unsigned char* lds, int wave, int lane, int which, int gb, int NGB) {
    unsigned char* ws = a->ws;
    constexpr int I0 = 22 * 16, I1 = 4 * 44, I2 = 14 * 16, I3 = 4 * 16;
    const int NIT = which == 0 ? I0 + I1 + I2 : I0 + I1 + I3;
    for (int it = gb; it < NIT; it += NGB) {
        int r = it;
        if (r < I0) { const int pn = r >> 4, kb = r & 15;
            convert_tile(which == 0 ? a->in[8] : a->in[28], 1024, 5632, which == 0 ? a->in[7] : a->in[27], (bf16_t*)(ws + (which == 0 ? WS_W1I : WS_W2I)), pn, 64 * kb, 0, lds, wave, lane); continue; }
        r -= I0;
        if (r < I1) { const int pn = r / 44, kb = r % 44; convert_tile(which == 0 ? a->in[9] : a->in[29], DFF, 1024, nullptr, (bf16_t*)(ws + (which == 0 ? WS_W1O : WS_W2O)), pn, 64 * kb, 1, lds, wave, lane); continue; }
        r -= I1;
        if (which == 0) { const int pn = r >> 4, kb = r & 15; convert_tile(a->in[11], 1024, 3336, a->in[10], (bf16_t*)(ws + WS_WIN), pn, 64 * kb, 2, lds, wave, lane); }
        else { const int pn = r >> 4, kb = r & 15; convert_tile(a->in[12], 1024, 1024, nullptr, (bf16_t*)(ws + WS_WOUT), pn, 64 * kb, 1, lds, wave, lane); }
    }
    __syncthreads();
}
__device__ __forceinline__ void phase0(CArgsP a, LAS unsigned char* lds, int wave, int lane) {
    const int gw = blockIdx.x * 8 + wave, NGW = gridDim.x * 8;
    unsigned char* ws = a->ws;
    convert_weights(a, lds, wave, lane, 0, blockIdx.x, gridDim.x);
    {
        bf16_t* WL = (bf16_t*)(ws + WS_WLORA);
        const int gt = blockIdx.x * 512 + threadIdx.x, NG = gridDim.x * 512;
        for (int idx = gt; idx < NLORA * KLORA; idx += NG) {
            const int n = idx >> 8, k = idx & 255; float v = 0.f;
            if (n < 512) { if (k < 64) v = a->in[18][k * 512 + n]; }
            else if (n < 1024) { if (k >= 64 && k < 128) v = a->in[20][(k - 64) * 512 + (n - 512)]; }
            else { if (k >= 128) v = a->in[21][(k - 128) * 512 + (n - 1024)]; }
            WL[idx] = (bf16_t)f2bf(v);
        }
    }
    {
        bf16_t* XB = (bf16_t*)(ws + WS_XB); float* rq0 = (float*)(ws + WS_ROWSQ0); float* rq1 = (float*)(ws + WS_ROWSQ1); float* rq2 = (float*)(ws + WS_ROWSQ2);
#pragma unroll 2
        for (int m = gw; m < MROWS; m += NGW) {
            const float* xrow = m < TP ? a->in[0] + (size_t)m * DM : a->in[1] + (size_t)(m - TP) * DM;
            const f32x4* xr = (const f32x4*)xrow + lane; f32x4 v[4]; float s = 0.f;
#pragma unroll
            for (int j = 0; j < 4; ++j) { v[j] = xr[64 * j]; s += (v[j].x * v[j].x + v[j].y * v[j].y) + (v[j].z * v[j].z + v[j].w * v[j].w); }
            s = wave_sum(s);
            u32x2* o8 = (u32x2*)(XB + (size_t)m * DM) + lane;
#pragma unroll
            for (int j = 0; j < 4; ++j) { u32x2 w; w.x = pk2(v[j].x, v[j].y); w.y = pk2(v[j].z, v[j].w); o8[64 * j] = w; }
            if (lane == 0) { rq0[m] = s; rq1[m] = 0.f; rq2[m] = 0.f; }
        }
    }
}

using pg8::cvt_pk_bf16;
struct EpiSwiglu {
    static constexpr bool PERM = true, AFTER_DRAIN = false;
    bf16_t* H; const float* rowsq;
    __device__ __forceinline__ void operator()(const pg8::f32x4 (&acc)[2][2][4][2], const pg8::Unit& u, int wr, int wc, int fr, int fq) const {
        const int row0 = u.pm * 256 + wr * 64 + fr, col0 = u.pn * 128 + wc * 32 + 8 * fq;
#pragma unroll
        for (int ai = 0; ai < 2; ++ai)
#pragma unroll
            for (int m = 0; m < 4; ++m) {
                const int row = row0 + ai * 128 + m * 16;
                const float rs = rsqrtf(rowsq[row] * (1.f / 1024.f) + 1e-6f);
                float h[8];
#pragma unroll
                for (int n = 0; n < 2; ++n)
#pragma unroll
                    for (int j = 0; j < 4; ++j) { const float g = acc[ai][0][m][n][j] * rs, up = acc[ai][1][m][n][j] * rs; h[4 * n + j] = g * __builtin_amdgcn_rcpf(1.f + __expf(-g)) * up; }
                u32x4 w; w.x = cvt_pk_bf16(h[0], h[1]); w.y = cvt_pk_bf16(h[2], h[3]); w.z = cvt_pk_bf16(h[4], h[5]); w.w = cvt_pk_bf16(h[6], h[7]);
                *(u32x4*)(H + (size_t)row * DFF + col0) = w;
            }
    }
};
struct EpiResid {
    static constexpr bool PERM = false, AFTER_DRAIN = false;
    const float* xp; const float* xs; float* Y; bf16_t* XB; float* rowsq_out; float scale; int inplace;
    __device__ __forceinline__ void operator()(const pg8::f32x4 (&acc)[2][2][4][2], const pg8::Unit& u, int wr, int wc, int fr, int fq) const {
        const int row0 = u.pm * 256 + wr * 64 + fr, col0 = u.pn * 256 + wc * 32 + 4 * fq;
#pragma unroll
        for (int ai = 0; ai < 2; ++ai)
#pragma unroll
            for (int m = 0; m < 4; ++m) {
                const int row = row0 + ai * 128 + m * 16;
                float* yo = Y + (size_t)row * DM;
                const float* base = inplace ? yo : (row < TP ? xp + (size_t)row * DM : xs + (size_t)(row - TP) * DM);
                float ss = 0.f;
#pragma unroll
                for (int bj = 0; bj < 2; ++bj)
#pragma unroll
                    for (int n = 0; n < 2; ++n) {
                        const int c = col0 + bj * 128 + n * 16;
                        const f32x4 b = *(const f32x4*)(base + c); const f32x4 o = b + acc[ai][bj][m][n] * scale;
                        __builtin_nontemporal_store(o, (f32x4*)(yo + c));
                        if (XB) { u32x2 w; w.x = cvt_pk_bf16(o[0], o[1]); w.y = cvt_pk_bf16(o[2], o[3]); *(u32x2*)(XB + (size_t)row * DM + c) = w; }
                        ss += (o[0] * o[0] + o[1] * o[1]) + (o[2] * o[2] + o[3] * o[3]);
                    }
                if (rowsq_out) { ss += __shfl_xor(ss, 16); ss += __shfl_xor(ss, 32); if (fq == 0) atomicAdd(rowsq_out + row, ss); }
            }
    }
};
struct EpiProj {
    static constexpr bool PERM = true, AFTER_DRAIN = false;
    const float* rowsq; unsigned char* ws; float* out; const float *gq, *gk, *bfg;
    __device__ __forceinline__ void operator()(const pg8::f32x4 (&acc)[2][2][4][2], const pg8::Unit& u, int wr, int wc, int fr, int fq) const {
        const int row0 = u.pm * 256 + wr * 64 + fr, pn = u.pn;
        if (pn < 6) {
            const int kind = pn >> 1, head = (pn & 1) * 4 + wc, colh = head * 64 + 8 * fq;
            f32x4 gg[2][2];
#pragma unroll
            for (int bj = 0; bj < 2; ++bj)
#pragma unroll
                for (int n = 0; n < 2; ++n) {
                    gg[bj][n] = (f32x4){1.f, 1.f, 1.f, 1.f};
                    if (kind == 0) gg[bj][n] = *(const f32x4*)(gq + 32 * bj + 8 * fq + 4 * n) * QSCALE;
                    if (kind == 1) gg[bj][n] = *(const f32x4*)(gk + 32 * bj + 8 * fq + 4 * n);
                }
#pragma unroll
            for (int ai = 0; ai < 2; ++ai)
#pragma unroll
                for (int m = 0; m < 4; ++m) {
                    const int row = row0 + ai * 128 + m * 16;
                    const float rs = rsqrtf(rowsq[row] * (1.f / 1024.f) + 1e-6f);
                    f32x4 v[2][2]; float ss = 0.f;
#pragma unroll
                    for (int bj = 0; bj < 2; ++bj)
#pragma unroll
                        for (int n = 0; n < 2; ++n) { v[bj][n] = acc[ai][bj][m][n] * rs; const f32x4 t = v[bj][n]; ss += (t[0] * t[0] + t[1] * t[1]) + (t[2] * t[2] + t[3] * t[3]); }
                    if (kind < 2) {
                        ss += __shfl_xor(ss, 16); ss += __shfl_xor(ss, 32);
                        const float nrm = rsqrtf(ss * (1.f / 64.f) + 1e-6f);
#pragma unroll
                        for (int bj = 0; bj < 2; ++bj)
#pragma unroll
                            for (int n = 0; n < 2; ++n) v[bj][n] = v[bj][n] * nrm * gg[bj][n];
                    }
                    bf16_t* dstb = (bf16_t*)(ws + WS_Q + (size_t)kind * (WS_K - WS_Q)) + (size_t)row * 512 + colh;
#pragma unroll
                    for (int bj = 0; bj < 2; ++bj) {
                        u32x4 w; w.x = cvt_pk_bf16(v[bj][0][0], v[bj][0][1]); w.y = cvt_pk_bf16(v[bj][0][2], v[bj][0][3]); w.z = cvt_pk_bf16(v[bj][1][0], v[bj][1][1]); w.w = cvt_pk_bf16(v[bj][1][2], v[bj][1][3]);
                        *(u32x4*)(dstb + 32 * bj) = w;
                    }
                    if (kind >= 1) {
                        float* dstf = (row < TP ? out + OFF_KP + (size_t)(kind - 1) * (OFF_VP - OFF_KP) + (size_t)row * 512 : out + OFF_KS + (size_t)(kind - 1) * (OFF_VS - OFF_KS) + (size_t)(row - TP) * 512) + colh;
#pragma unroll
                        for (int bj = 0; bj < 2; ++bj) { __builtin_nontemporal_store(v[bj][0], (f32x4*)(dstf + 32 * bj)); __builtin_nontemporal_store(v[bj][1], (f32x4*)(dstf + 32 * bj + 4)); }
                    }
                }
        } else if (pn < 13) {
            const int colr = (pn - 6) * 256 + 64 * wc + 8 * fq;
#pragma unroll
            for (int ai = 0; ai < 2; ++ai)
#pragma unroll
                for (int m = 0; m < 4; ++m) {
                    const int row = row0 + ai * 128 + m * 16;
                    const float rs = rsqrtf(rowsq[row] * (1.f / 1024.f) + 1e-6f);
                    const bool last = (row == TP - 1) || (row >= TP && ((row - TP) & 15) == 15);
                    float* dstf = (row < TP ? out + OFF_SHP : out + OFF_SHS + (size_t)((row - TP) >> 4) * RWP) + colr;
#pragma unroll
                    for (int bj = 0; bj < 2; ++bj) {
                        const f32x4 v0 = acc[ai][bj][m][0] * rs, v1 = acc[ai][bj][m][1] * rs;
                        u32x4 w; w.x = cvt_pk_bf16(v0[0], v0[1]); w.y = cvt_pk_bf16(v0[2], v0[3]); w.z = cvt_pk_bf16(v1[0], v1[1]); w.w = cvt_pk_bf16(v1[2], v1[3]);
                        *(u32x4*)((bf16_t*)(ws + WS_PRW) + (size_t)row * RWP + colr + 32 * bj) = w;
                        if (last) { *(f32x4*)(dstf + 32 * bj) = v0; *(f32x4*)(dstf + 32 * bj + 4) = v1; }
                    }
                }
        } else {
            if (wc == 0 && fq == 0) {
                const f32x4 b0 = *(const f32x4*)(bfg), b1 = *(const f32x4*)(bfg + 4);
#pragma unroll
                for (int ai = 0; ai < 2; ++ai)
#pragma unroll
                    for (int m = 0; m < 4; ++m) {
                        const int row = row0 + ai * 128 + m * 16;
                        const float rs = rsqrtf(rowsq[row] * (1.f / 1024.f) + 1e-6f);
                        const f32x4 z0 = acc[ai][0][m][0] * rs + b0, z1 = acc[ai][0][m][1] * rs + b1;
                        f32x4 l0, l1;
#pragma unroll
                        for (int j = 0; j < 4; ++j) { l0[j] = fminf(z0[j], 0.f) - __logf(1.f + __expf(-fabsf(z0[j]))); l1[j] = fminf(z1[j], 0.f) - __logf(1.f + __expf(-fabsf(z1[j]))); }
                        float* LOGF = (float*)(ws + WS_LOGF); *(f32x4*)(LOGF + (size_t)row * 8) = l0; *(f32x4*)(LOGF + (size_t)row * 8 + 4) = l1;
                        float* dstf = row < TP ? out + OFF_LFP + (size_t)row * 8 : out + OFF_LFS + (size_t)(row - TP) * 8;
                        *(f32x4*)dstf = l0; *(f32x4*)(dstf + 4) = l1;
                    }
            }
        }
    }
};
struct EpiBf16N {
    static constexpr bool PERM = true, AFTER_DRAIN = false;
    bf16_t* O; int ldc;
    __device__ __forceinline__ void operator()(const pg8::f32x4 (&acc)[2][2][4][2], const pg8::Unit& u, int wr, int wc, int fr, int fq) const {
        const int row0 = u.pm * 256 + wr * 64 + fr, col0 = u.pn * 256 + wc * 32 + 8 * fq;
#pragma unroll
        for (int ai = 0; ai < 2; ++ai)
#pragma unroll
            for (int m = 0; m < 4; ++m) {
                bf16_t* rowp = O + (size_t)(row0 + ai * 128 + m * 16) * ldc + col0;
#pragma unroll
                for (int bj = 0; bj < 2; ++bj) {
                    const f32x4 v0 = acc[ai][bj][m][0], v1 = acc[ai][bj][m][1];
                    u32x4 w; w.x = cvt_pk_bf16(v0[0], v0[1]); w.y = cvt_pk_bf16(v0[2], v0[3]); w.z = cvt_pk_bf16(v1[0], v1[1]); w.w = cvt_pk_bf16(v1[2], v1[3]);
                    *(u32x4*)(rowp + bj * 128) = w;
                }
            }
    }
};

__device__ __forceinline__ void phase4(CArgsP a, int wave, int lane) {
    unsigned char* ws = a->ws;
    const bf16_t* PRW = (const bf16_t*)(ws + WS_PRW); bf16_t* LA = (bf16_t*)(ws + WS_LORAA);
    const int gw = blockIdx.x * 8 + wave, NGW = gridDim.x * 8;
    const f32x4 mu = *(const f32x4*)(a->in[16] + 1536 + 4 * lane);
#pragma unroll 8
    for (int m = gw; m < MROWS; m += NGW) {
        const u32x2 pw = *(const u32x2*)(PRW + (size_t)m * RWP + 1536 + 4 * lane);
        f32x4 p = {bf2f(pw.x & 0xffffu), bf2f(pw.x >> 16), bf2f(pw.y & 0xffffu), bf2f(pw.y >> 16)};
        f32x4 q = {0.f, 0.f, 0.f, 0.f};
        const bool first = (m == 0) || (m >= TP && ((m - TP) & 15) == 0);
        if (!first) { const u32x2 qw = *(const u32x2*)(PRW + (size_t)(m - 1) * RWP + 1536 + 4 * lane); q = (f32x4){bf2f(qw.x & 0xffffu), bf2f(qw.x >> 16), bf2f(qw.y & 0xffffu), bf2f(qw.y >> 16)}; }
        else if (m >= TP) q = *(const f32x4*)(a->in[6] + (size_t)((m - TP) >> 4) * RWP + 1536 + 4 * lane);
        const f32x4 xs = p + (q - p) * mu;
        float o[4];
#pragma unroll
        for (int j = 0; j < 4; ++j) { const float e = __expf(lane < 16 ? 2.f * xs[j] : -xs[j]); const float rc = __builtin_amdgcn_rcpf(1.f + e); o[j] = lane < 16 ? 1.f - 2.f * rc : (lane < 32 ? xs[j] : rc); }
        u32x2 w; w.x = pk2(o[0], o[1]); w.y = pk2(o[2], o[3]);
        *(u32x2*)(LA + (size_t)m * KLORA + 4 * lane) = w;
    }
    if (blockIdx.x < 64) {
        const float* LOGF = (const float*)(ws + WS_LOGF); float* CUM = (float*)(ws + WS_CUM); float* TT = (float*)(ws + WS_TT);
        const int tile = blockIdx.x, h = wave, t0 = tile * 256 + 4 * lane;
        float v0 = LOGF[(size_t)(t0 + 0) * 8 + h], v1 = LOGF[(size_t)(t0 + 1) * 8 + h], v2 = LOGF[(size_t)(t0 + 2) * 8 + h], v3 = LOGF[(size_t)(t0 + 3) * 8 + h];
        v1 += v0; v2 += v1; v3 += v2;
        float inc = v3;
#pragma unroll
        for (int o = 1; o < 64; o <<= 1) { const float t = __shfl_up(inc, o); if (lane >= o) inc += t; }
        const float excl = inc - v3;
        CUM[(size_t)(t0 + 0) * 8 + h] = excl + v0; CUM[(size_t)(t0 + 1) * 8 + h] = excl + v1; CUM[(size_t)(t0 + 2) * 8 + h] = excl + v2; CUM[(size_t)(t0 + 3) * 8 + h] = excl + v3;
        if (lane == 63) TT[tile * 8 + h] = inc;
    }
}
__device__ __forceinline__ void cum_fixup(CArgsP a) {
    if (blockIdx.x < 64) {
        float* CUM = (float*)(a->ws + WS_CUM); const float* TT = (const float*)(a->ws + WS_TT);
        const int tile = blockIdx.x, h = threadIdx.x & 7;
        float pre = 0.f;
        for (int t = 0; t < tile; ++t) pre += TT[t * 8 + h];
#pragma unroll
        for (int i = 0; i < 4; ++i) { const int idx = threadIdx.x + 512 * i; CUM[(size_t)tile * 2048 + idx] += pre; }
    }
}

constexpr int AT_KVBUF = 17664, AT_VT = 8192, AT_CK = 17408, AT_MISC = 2 * AT_KVBUF, AT_VS = 144;
__device__ __forceinline__ int slotpos(int kv) { const int w = kv & 15; return (kv & ~15) + 8 * ((w >> 2) & 1) + (w & 3) + ((w >> 3) << 2); }
__device__ __forceinline__ void attn_unit(LAS unsigned char* lds, CArgsP a, int h, int qb, float thr) {
    const int tid = threadIdx.x, lane = tid & 63, wid = tid >> 6, r32 = lane & 31, hi = lane >> 5;
    const bf16_t* QB = (const bf16_t*)(a->ws + WS_Q); const bf16_t* KB = (const bf16_t*)(a->ws + WS_K); const bf16_t* VB = (const bf16_t*)(a->ws + WS_V);
    const float* CUM = (const float*)(a->ws + WS_CUM); bf16_t* MIX = (bf16_t*)(a->ws + WS_XB);
    const int q0 = qb * 256, qrow = q0 + wid * 32 + r32;
    bf16x8 qr[4];
#pragma unroll
    for (int d0 = 0; d0 < 4; ++d0) qr[d0] = *(const bf16x8*)(QB + (size_t)qrow * 512 + h * 64 + d0 * 16 + hi * 8);
    const float cref = CUM[(size_t)q0 * 8 + h];
    const int jt_hi = 4 * qb + 3;
    LAS int* s_lo = (LAS int*)(lds + AT_MISC);
    __syncthreads();
    if (tid == 0) *s_lo = 4 * qb;
    __syncthreads();
    {
        const float cq0 = cref;
        if (tid < 4 * qb) { const float cj = CUM[(size_t)(64 * tid + 63) * 8 + h]; if (cq0 - cj >= -thr) atomicMin((int*)s_lo, tid); }
    }
    __syncthreads();
    const int jt_lo = *s_lo;
    const int kvl = tid & 63, ch = tid >> 6;
    u32x4 kreg, vreg; float ckreg = 0.f;
    auto gload = [&](int jt) {
        const size_t off = (size_t)(64 * jt + kvl) * 512 + h * 64 + ch * 8;
        kreg = *(const u32x4*)(KB + off); vreg = *(const u32x4*)(VB + off);
        if (tid < 64) ckreg = (CUM[(size_t)(64 * jt + tid) * 8 + h] - cref) * LOG2E;
    };
    u32x4 kreg2, vreg2; float ckreg2 = 0.f;
    auto gload2 = [&](int jt) {
        const size_t off = (size_t)(64 * jt + kvl) * 512 + h * 64 + ch * 8;
        kreg2 = *(const u32x4*)(KB + off); vreg2 = *(const u32x4*)(VB + off);
        if (tid < 64) ckreg2 = (CUM[(size_t)(64 * jt + tid) * 8 + h] - cref) * LOG2E;
    };
    const int sp2 = 2 * slotpos(kvl);
    auto lstore = [&](int b) {
        LAS unsigned char* buf = lds + b * AT_KVBUF;
        *(LAS u32x4*)(buf + ch * 1024 + kvl * 16) = kreg;
        LAS unsigned char* vt = buf + AT_VT + (8 * ch) * AT_VS + sp2;
        *(LAS unsigned short*)(vt + 0 * AT_VS) = (unsigned short)(vreg.x & 0xffffu); *(LAS unsigned short*)(vt + 1 * AT_VS) = (unsigned short)(vreg.x >> 16);
        *(LAS unsigned short*)(vt + 2 * AT_VS) = (unsigned short)(vreg.y & 0xffffu); *(LAS unsigned short*)(vt + 3 * AT_VS) = (unsigned short)(vreg.y >> 16);
        *(LAS unsigned short*)(vt + 4 * AT_VS) = (unsigned short)(vreg.z & 0xffffu); *(LAS unsigned short*)(vt + 5 * AT_VS) = (unsigned short)(vreg.z >> 16);
        *(LAS unsigned short*)(vt + 6 * AT_VS) = (unsigned short)(vreg.w & 0xffffu); *(LAS unsigned short*)(vt + 7 * AT_VS) = (unsigned short)(vreg.w >> 16);
        if (tid < 64) *(LAS float*)(buf + AT_CK + 4 * tid) = ckreg;
    };
    gload(jt_hi); lstore(0);
    if (jt_lo < jt_hi) gload(jt_hi - 1);
    __syncthreads();
    float m_run = -INFINITY, l_run = 0.f;
    f32x16 o0 = {}, o1 = {};
    for (int jt = jt_hi; jt >= jt_lo; --jt) {
        const int b = (jt_hi - jt) & 1;
        if (jt - 2 >= jt_lo) gload2(jt - 2);
        LAS unsigned char* buf = lds + b * AT_KVBUF;
        if (64 * (jt - 4 * qb) <= 32 * wid + 31) {
        f32x16 p0 = {}, p1 = {};
#pragma unroll
        for (int d0 = 0; d0 < 4; ++d0) {
            const bf16x8 a0 = *(const LAS bf16x8*)(buf + (2 * d0 + hi) * 1024 + r32 * 16);
            const bf16x8 a1 = *(const LAS bf16x8*)(buf + (2 * d0 + hi) * 1024 + (32 + r32) * 16);
            p0 = __builtin_amdgcn_mfma_f32_32x32x16_bf16(a0, qr[d0], p0, 0, 0, 0);
            p1 = __builtin_amdgcn_mfma_f32_32x32x16_bf16(a1, qr[d0], p1, 0, 0, 0);
        }
        const int kvb = 64 * jt;
        float mx = -INFINITY;
        if (jt < 4 * qb) {
#pragma unroll
            for (int g = 0; g < 4; ++g) {
                const f32x4 c0 = *(const LAS f32x4*)(buf + AT_CK + 4 * (8 * g + 4 * hi));
                const f32x4 c1 = *(const LAS f32x4*)(buf + AT_CK + 4 * (32 + 8 * g + 4 * hi));
#pragma unroll
                for (int j = 0; j < 4; ++j) { const float s0 = p0[4 * g + j] - c0[j], s1 = p1[4 * g + j] - c1[j]; p0[4 * g + j] = s0; p1[4 * g + j] = s1; mx = fmaxf(mx, fmaxf(s0, s1)); }
            }
        } else {
#pragma unroll
            for (int g = 0; g < 4; ++g) {
                const f32x4 c0 = *(const LAS f32x4*)(buf + AT_CK + 4 * (8 * g + 4 * hi));
                const f32x4 c1 = *(const LAS f32x4*)(buf + AT_CK + 4 * (32 + 8 * g + 4 * hi));
#pragma unroll
                for (int j = 0; j < 4; ++j) {
                    const int kv = kvb + 8 * g + 4 * hi + j;
                    float s0 = p0[4 * g + j] - c0[j]; if (kv > qrow) s0 = -INFINITY;
                    float s1 = p1[4 * g + j] - c1[j]; if (kv + 32 > qrow) s1 = -INFINITY;
                    p0[4 * g + j] = s0; p1[4 * g + j] = s1; mx = fmaxf(mx, fmaxf(s0, s1));
                }
            }
        }
        mx = fmaxf(mx, __shfl_xor(mx, 32));
        float ps = 0.f;
        if (__any(mx > m_run)) {
            const float m_new = fmaxf(m_run, mx);
            const float alpha = __builtin_amdgcn_exp2f(m_run - m_new);
            m_run = m_new;
            l_run *= alpha;
#pragma unroll
            for (int r = 0; r < 16; ++r) { o0[r] *= alpha; o1[r] *= alpha; }
        }
#pragma unroll
        for (int r = 0; r < 16; ++r) { p0[r] = __builtin_amdgcn_exp2f(p0[r] - m_run); p1[r] = __builtin_amdgcn_exp2f(p1[r] - m_run); ps += p0[r] + p1[r]; }
        l_run += ps;
        bf16x8 pf[4];
#pragma unroll
        for (int bb = 0; bb < 2; ++bb) {
            u32x4 w0, w1;
            w0.x = cvt_pk_bf16(p0[8 * bb + 0], p0[8 * bb + 1]); w0.y = cvt_pk_bf16(p0[8 * bb + 2], p0[8 * bb + 3]); w0.z = cvt_pk_bf16(p0[8 * bb + 4], p0[8 * bb + 5]); w0.w = cvt_pk_bf16(p0[8 * bb + 6], p0[8 * bb + 7]);
            w1.x = cvt_pk_bf16(p1[8 * bb + 0], p1[8 * bb + 1]); w1.y = cvt_pk_bf16(p1[8 * bb + 2], p1[8 * bb + 3]); w1.z = cvt_pk_bf16(p1[8 * bb + 4], p1[8 * bb + 5]); w1.w = cvt_pk_bf16(p1[8 * bb + 6], p1[8 * bb + 7]);
            pf[bb] = __builtin_bit_cast(bf16x8, w0); pf[2 + bb] = __builtin_bit_cast(bf16x8, w1);
        }
#pragma unroll
        for (int kb = 0; kb < 4; ++kb) {
            const bf16x8 v0 = *(const LAS bf16x8*)(buf + AT_VT + (r32) * AT_VS + (16 * kb + 8 * hi) * 2);
            const bf16x8 v1 = *(const LAS bf16x8*)(buf + AT_VT + (32 + r32) * AT_VS + (16 * kb + 8 * hi) * 2);
            o0 = __builtin_amdgcn_mfma_f32_32x32x16_bf16(v0, pf[kb], o0, 0, 0, 0);
            o1 = __builtin_amdgcn_mfma_f32_32x32x16_bf16(v1, pf[kb], o1, 0, 0, 0);
        }
        }
        if (jt > jt_lo) lstore(b ^ 1);
        asm volatile("s_waitcnt lgkmcnt(0)\n\ts_barrier" ::: "memory");
        kreg = kreg2; vreg = vreg2; ckreg = ckreg2;
    }
    const float lt = l_run + __shfl_xor(l_run, 32);
    const float inv = 1.f / lt;
    bf16_t* orow = MIX + (size_t)qrow * DM + h * 64 + 4 * hi;
#pragma unroll
    for (int g = 0; g < 4; ++g) {
        u32x2 w0, w1;
        w0.x = cvt_pk_bf16(o0[4 * g] * inv, o0[4 * g + 1] * inv); w0.y = cvt_pk_bf16(o0[4 * g + 2] * inv, o0[4 * g + 3] * inv);
        w1.x = cvt_pk_bf16(o1[4 * g] * inv, o1[4 * g + 1] * inv); w1.y = cvt_pk_bf16(o1[4 * g + 2] * inv, o1[4 * g + 3] * inv);
        *(u32x2*)(orow + 8 * g) = w0; *(u32x2*)(orow + 32 + 8 * g) = w1;
    }
}

constexpr int SA_C = 0, SA_Q = 4352, SA_SC = 8448, SA_NK = PAST + TSS;
__device__ __forceinline__ void attn_sample_unit(LAS unsigned char* lds, CArgsP a, int b, int h) {
    const int tid = threadIdx.x, lane = tid & 63, wid = tid >> 6;
    LAS float* C = (LAS float*)(lds + SA_C); LAS float* Qs = (LAS float*)(lds + SA_Q); LAS float* SC = (LAS float*)(lds + SA_SC);
    const float* LOGF = (const float*)(a->ws + WS_LOGF); const bf16_t* QB = (const bf16_t*)(a->ws + WS_Q); bf16_t* MIX = (bf16_t*)(a->ws + WS_XB);
    const float* ck = a->in[2]; const float* cv = a->in[3]; const float* clf = a->in[4];
    const float* nk = a->out + OFF_KS; const float* nv = a->out + OFF_VS;
    __syncthreads();
    if (wid == 0) {
        float v[17]; float run = 0.f;
#pragma unroll
        for (int i = 0; i < 17; ++i) {
            const int j = 17 * lane + i; float x = 0.f;
            if (j < PAST) x = clf[((size_t)b * PAST + j) * 8 + h]; else if (j < SA_NK) x = LOGF[(size_t)(TP + 16 * b + (j - PAST)) * 8 + h];
            run += x; v[i] = run;
        }
        float inc = run;
#pragma unroll
        for (int o = 1; o < 64; o <<= 1) { const float t = __shfl_up(inc, o); if (lane >= o) inc += t; }
        const float excl = inc - run;
#pragma unroll
        for (int i = 0; i < 17; ++i) { const int j = 17 * lane + i; if (j < SA_NK) C[j] = excl + v[i]; }
    } else {
        for (int i = tid - 64; i < 1024; i += 448) { const int t = i >> 6, d = i & 63; Qs[i] = bf2f(QB[(size_t)(TP + 16 * b + t) * 512 + h * 64 + d]); }
    }
    __syncthreads();
    for (int j = tid; j < SA_NK; j += 512) {
        const float* kp = j < PAST ? ck + (((size_t)b * PAST + j) * 8 + h) * 64 : nk + (size_t)(16 * b + (j - PAST)) * 512 + h * 64;
        float acc[16];
#pragma unroll
        for (int t = 0; t < 16; ++t) acc[t] = 0.f;
#pragma unroll
        for (int hb = 0; hb < 2; ++hb) {
            f32x4 kr[8];
#pragma unroll
            for (int i = 0; i < 8; ++i) kr[i] = *(const f32x4*)(kp + 32 * hb + 4 * i);
#pragma unroll
            for (int i = 0; i < 8; ++i) {
                asm volatile("" ::: "memory");
                const f32x4 k4 = kr[i];
#pragma unroll
                for (int t = 0; t < 16; ++t) { const f32x4 q4 = *(const LAS f32x4*)(Qs + t * 64 + 32 * hb + 4 * i); acc[t] += (q4[0] * k4[0] + q4[1] * k4[1]) + (q4[2] * k4[2] + q4[3] * k4[3]); }
            }
        }
        const float cj = C[j];
#pragma unroll
        for (int t = 0; t < 16; ++t) SC[t * SA_NK + j] = acc[t] + (C[PAST + t] - cj) * LOG2E;
    }
    __syncthreads();
#pragma unroll
    for (int tt = 0; tt < 2; ++tt) {
        const int t = 2 * wid + tt; LAS float* row = SC + t * SA_NK;
        float mx = -INFINITY;
        for (int j = lane; j < SA_NK; j += 64) { if (j > PAST + t) row[j] = -INFINITY; mx = fmaxf(mx, row[j]); }
        mx = wave_max(mx);
        float sum = 0.f;
        for (int j = lane; j < SA_NK; j += 64) { const float p = __builtin_amdgcn_exp2f(row[j] - mx); row[j] = p; sum += p; }
        sum = wave_sum(sum);
        const float inv = 1.f / sum;
        for (int j = lane; j < SA_NK; j += 64) row[j] *= inv;
    }
    __syncthreads();
    {
        float acc[16];
#pragma unroll
        for (int t = 0; t < 16; ++t) acc[t] = 0.f;
        const float* vp = cv + ((size_t)b * PAST * 8 + h) * 64 + lane;
        float vv[8], vn8[8];
#pragma unroll
        for (int i = 0; i < 8; ++i) vv[i] = vp[(size_t)(wid + 8 * i) * 512];
#pragma unroll 1
        for (int j0 = wid; j0 < PAST; j0 += 64) {
            const int jn = (j0 + 64 < PAST) ? j0 + 64 : j0;
#pragma unroll
            for (int i = 0; i < 8; ++i) vn8[i] = vp[(size_t)(jn + 8 * i) * 512];
#pragma unroll
            for (int i = 0; i < 8; ++i) {
                asm volatile("" ::: "memory");
#pragma unroll
                for (int t = 0; t < 16; ++t) acc[t] += SC[t * SA_NK + j0 + 8 * i] * vv[i];
            }
#pragma unroll
            for (int i = 0; i < 8; ++i) vv[i] = vn8[i];
        }
        {
            const float* vn = nv + (size_t)(16 * b) * 512 + h * 64 + lane;
            const float v0 = vn[(size_t)wid * 512], v1 = vn[(size_t)(wid + 8) * 512];
#pragma unroll
            for (int t = 0; t < 16; ++t) acc[t] += SC[t * SA_NK + PAST + wid] * v0 + SC[t * SA_NK + PAST + wid + 8] * v1;
        }
        __syncthreads();
        LAS float* red = SC;
#pragma unroll
        for (int t = 0; t < 16; ++t) red[(wid * 16 + t) * 64 + lane] = acc[t];
        __syncthreads();
        {
            const int t = tid >> 5, d = 2 * (tid & 31);
            float a0 = 0.f, a1 = 0.f;
#pragma unroll
            for (int w = 0; w < 8; ++w) { a0 += red[(w * 16 + t) * 64 + d]; a1 += red[(w * 16 + t) * 64 + d + 1]; }
            *(unsigned*)(MIX + (size_t)(TP + 16 * b + t) * DM + h * 64 + d) = pk2(a0, a1);
        }
    }
}

constexpr int NSEG = 64, SEGCH = TP / 16 / NSEG;
constexpr size_t WS_PM = WS_SEG, WS_UM = WS_W1I, WS_SS = WS_LORAA;
constexpr int SC_CHB = 7 * 16 * 64 * 4, SC_Y = 2 * SC_CHB, SC_HALF = SC_Y + 16 * 64 * 4;
static_assert(2 * SC_HALF <= 131072, "scan LDS");
__device__ __forceinline__ float wave_sum_fast(float x) {
    x += dpp_f<0xB1>(x); x += dpp_f<0x4E>(x); x += dpp_f<0x141>(x); x += dpp_f<0x140>(x);
    x += __builtin_bit_cast(float, __builtin_amdgcn_update_dpp(0, __builtin_bit_cast(int, x), 0x142, 0xa, 0xf, false));
    x += __builtin_bit_cast(float, __builtin_amdgcn_update_dpp(0, __builtin_bit_cast(int, x), 0x143, 0xc, 0xf, false));
    return __builtin_bit_cast(float, __builtin_amdgcn_readlane(__builtin_bit_cast(int, x), 63));
}
struct ScanRaw { unsigned prk[4], pvq[4], qkv[4], lwa[4]; unsigned short lg[4]; };
struct ScanUnit { int seq, h, c0; const float* S0; float* Sout; float* Pout; };
typedef float f32x2 __attribute__((ext_vector_type(2)));
struct V8 { f32x2 p[4]; };
__device__ __forceinline__ V8 ld8(const LAS float* p) {
    const f32x4 a = *(const LAS f32x4*)p, b = *(const LAS f32x4*)(p + 4);
    V8 r; r.p[0] = __builtin_shufflevector(a, a, 0, 1); r.p[1] = __builtin_shufflevector(a, a, 2, 3); r.p[2] = __builtin_shufflevector(b, b, 0, 1); r.p[3] = __builtin_shufflevector(b, b, 2, 3); return r;
}
__device__ __forceinline__ float dot8(const V8& S, const V8& k) { f32x2 acc = S.p[0] * k.p[0]; acc = S.p[1] * k.p[1] + acc; acc = S.p[2] * k.p[2] + acc; acc = S.p[3] * k.p[3] + acc; return acc.x + acc.y; }
__device__ __forceinline__ float red8(float d) { d += dpp_f<0xB1>(d); d += dpp_f<0x4E>(d); d += dpp_f<0x141>(d); return d; }
__device__ __forceinline__ void upd8(V8& S, const V8& w, const V8& b, const V8& k, float sa, float vv) {
    const f32x2 sa2 = {sa, sa}, vv2 = {vv, vv};
#pragma unroll
    for (int i = 0; i < 4; ++i) { f32x2 t = vv2 * k.p[i]; t = sa2 * b.p[i] + t; S.p[i] = S.p[i] * w.p[i] + t; }
}
__device__ __forceinline__ void updp8(V8& S, const V8& w, const V8& b, float sa) {
    const f32x2 sa2 = {sa, sa};
#pragma unroll
    for (int i = 0; i < 4; ++i) { const f32x2 t = sa2 * b.p[i]; S.p[i] = S.p[i] * w.p[i] + t; }
}
template <int MODE>
__device__ __forceinline__ void scan_pair(LAS unsigned char* lds, CArgsP a, const ScanUnit u, int nch) {
    const int tid = threadIdx.x, lane = tid & 63, wid = tid >> 6, half = wid >> 2, hw = wid & 3, ks = lane & 7, vr0 = hw * 16 + (lane >> 3), vr1 = vr0 + 8;
    LAS unsigned char* hl = lds + half * SC_HALF;
    const bf16_t* PRW = (const bf16_t*)(a->ws + WS_PRW); const bf16_t* LORA = (const bf16_t*)(a->ws + WS_LORA); bf16_t* MIX = (bf16_t*)(a->ws + WS_XB);
    const int seq = u.seq, h = u.h, c0 = u.c0;
    const int rowbase = seq == 0 ? 0 : TP + 16 * (seq - 1);
    const int c_ = h * 64 + lane;
    const float mu_r = a->in[16][c_], mu_k = a->in[16][512 + c_], mu_v = a->in[16][1024 + c_], w0c = a->in[17][c_], a0c = a->in[19][c_];
    const float kkc = a->in[22][c_], kac = a->in[23][c_], rkc = a->in[24][c_], lng = a->in[25][c_], lnb = a->in[26][c_];
    V8 Sa, Sb, Pa, Pb;
#pragma unroll
    for (int i = 0; i < 4; ++i) {
        Sa.p[i] = (f32x2){0.f, 0.f}; Sb.p[i] = (f32x2){0.f, 0.f};
        Pa.p[i] = (f32x2){(8 * ks + 2 * i == vr0) ? 1.f : 0.f, (8 * ks + 2 * i + 1 == vr0) ? 1.f : 0.f};
        Pb.p[i] = (f32x2){(8 * ks + 2 * i == vr1) ? 1.f : 0.f, (8 * ks + 2 * i + 1 == vr1) ? 1.f : 0.f};
    }
    if (u.S0) {
        const float* sp = u.S0 + (size_t)vr0 * 64 + 8 * ks;
        const f32x4 s0 = *(const f32x4*)sp, s1 = *(const f32x4*)(sp + 4), s2 = *(const f32x4*)(sp + 512), s3 = *(const f32x4*)(sp + 516);
        Sa.p[0] = (f32x2){s0[0], s0[1]}; Sa.p[1] = (f32x2){s0[2], s0[3]}; Sa.p[2] = (f32x2){s1[0], s1[1]}; Sa.p[3] = (f32x2){s1[2], s1[3]};
        Sb.p[0] = (f32x2){s2[0], s2[1]}; Sb.p[1] = (f32x2){s2[2], s2[3]}; Sb.p[2] = (f32x2){s3[0], s3[1]}; Sb.p[3] = (f32x2){s3[2], s3[3]};
    }
    __syncthreads();
    ScanRaw R;
    float sh0[3];
    auto rawload = [&](int c) {
#pragma unroll
        for (int tt = 0; tt < 4; ++tt) {
            const int tl = 16 * c + 4 * hw + tt; const size_t m = (size_t)rowbase + tl;
            const unsigned pr = PRW[m * RWP + c_], pk = PRW[m * RWP + 512 + c_], pv = PRW[m * RWP + 1024 + c_];
            unsigned qr = 0, qk = 0, qv = 0;
            if (tl > 0) { qr = PRW[(m - 1) * RWP + c_]; qk = PRW[(m - 1) * RWP + 512 + c_]; qv = PRW[(m - 1) * RWP + 1024 + c_]; }
            else {
                sh0[0] = 0.f; sh0[1] = 0.f; sh0[2] = 0.f;
                if (seq > 0) { const float* s0 = a->in[6] + (size_t)(seq - 1) * RWP; sh0[0] = s0[c_]; sh0[1] = s0[512 + c_]; sh0[2] = s0[1024 + c_]; }
            }
            const unsigned lw = LORA[m * NLORA + c_], la = LORA[m * NLORA + 512 + c_];
            R.prk[tt] = pr | (pk << 16); R.pvq[tt] = pv | (qr << 16); R.qkv[tt] = qk | (qv << 16); R.lwa[tt] = lw | (la << 16);
            R.lg[tt] = LORA[m * NLORA + 1024 + c_];
        }
    };
    auto prep = [&](int c, int b) {
        LAS float* cb = (LAS float*)(hl + b * SC_CHB);
#pragma unroll
        for (int tt = 0; tt < 4; ++tt) {
            const int t = 4 * hw + tt, tl = 16 * c + t;
            const float pr = bf2f(R.prk[tt] & 0xffffu), pk = bf2f(R.prk[tt] >> 16), pv = bf2f(R.pvq[tt] & 0xffffu);
            float qr = bf2f(R.pvq[tt] >> 16), qk = bf2f(R.qkv[tt] & 0xffffu), qv = bf2f(R.qkv[tt] >> 16);
            if (tl == 0) { qr = sh0[0]; qk = sh0[1]; qv = sh0[2]; }
            const float xr = pr + (qr - pr) * mu_r, xk = pk + (qk - pk) * mu_k, xv = pv + (qv - pv) * mu_v;
            const float wp = w0c + bf2f(R.lwa[tt] & 0xffffu);
            const float w = __expf(-0.6065306597126334f * __builtin_amdgcn_rcpf(1.f + __expf(-wp)));
            const float av = __builtin_amdgcn_rcpf(1.f + __expf(-(a0c + bf2f(R.lwa[tt] >> 16))));
            float kk = xk * kkc;
            const float n2 = wave_sum_fast(kk * kk);
            kk = kk * rsqrtf(fmaxf(n2, 1e-24f));
            const float kp = xk * (1.f + (av - 1.f) * kac);
            cb[(0 * 16 + t) * 64 + lane] = w; cb[(1 * 16 + t) * 64 + lane] = kk; cb[(2 * 16 + t) * 64 + lane] = kk * av; cb[(3 * 16 + t) * 64 + lane] = kp;
            cb[(4 * 16 + t) * 64 + lane] = xr; cb[(5 * 16 + t) * 64 + lane] = xv; cb[(6 * 16 + t) * 64 + lane] = bf2f(R.lg[tt]);
        }
    };
    rawload(c0); prep(c0, 0);
    __syncthreads();
    LAS float* Y = (LAS float*)(hl + SC_Y);
    for (int ci = 0; ci < nch; ++ci) {
        const int b = ci & 1, c = c0 + ci;
        if (ci + 1 < nch) rawload(c + 1);
        const LAS float* cb = (const LAS float*)(hl + b * SC_CHB);
#pragma unroll 8
        for (int t = 0; t < 16; ++t) {
            const LAS float* p = cb + t * 64 + 8 * ks;
            const V8 w = ld8(p), kk = ld8(p + 1024), bb = ld8(p + 2048), kv = ld8(p + 3072);
            const float va = cb[(5 * 16 + t) * 64 + vr0], vb = cb[(5 * 16 + t) * 64 + vr1];
            float da = dot8(Sa, kk), db = dot8(Sb, kk);
            da = red8(da); db = red8(db);
            upd8(Sa, w, bb, kv, -da, va); upd8(Sb, w, bb, kv, -db, vb);
            if (MODE == 1) {
                float pa = dot8(Pa, kk), pb = dot8(Pb, kk);
                pa = red8(pa); pb = red8(pb);
                updp8(Pa, w, bb, -pa); updp8(Pb, w, bb, -pb);
            } else {
                const V8 rr = ld8(p + 4096);
                float ya = dot8(Sa, rr), yb = dot8(Sb, rr);
                ya = red8(ya); yb = red8(yb);
                if (ks == 0) { Y[t * 64 + vr0] = ya; Y[t * 64 + vr1] = yb; }
            }
        }
        __syncthreads();
        if (MODE == 0) {
#pragma unroll
            for (int tt = 0; tt < 4; ++tt) {
                const int t = 4 * hw + tt; const size_t m = (size_t)rowbase + 16 * c + t;
                const float y = Y[t * 64 + lane];
                const float mean = wave_sum_fast(y) * (1.f / 64.f); const float dv = y - mean;
                const float var = wave_sum_fast(dv * dv) * (1.f / 64.f);
                const float yn = dv * rsqrtf(var + 64e-5f) * lng + lnb;
                const float r = cb[(4 * 16 + t) * 64 + lane], kp = cb[(3 * 16 + t) * 64 + lane], v = cb[(5 * 16 + t) * 64 + lane], g = cb[(6 * 16 + t) * 64 + lane];
                const float rk = wave_sum_fast(r * kp * rkc);
                MIX[m * DM + 512 + c_] = (bf16_t)f2bf((yn + rk * v) * g);
            }
        }
        if (ci + 1 < nch) prep(c + 1, b ^ 1);
        __syncthreads();
    }
    if (u.Sout) {
        float* so = u.Sout + (size_t)vr0 * 64 + 8 * ks;
        *(f32x4*)so = (f32x4){Sa.p[0].x, Sa.p[0].y, Sa.p[1].x, Sa.p[1].y}; *(f32x4*)(so + 4) = (f32x4){Sa.p[2].x, Sa.p[2].y, Sa.p[3].x, Sa.p[3].y};
        *(f32x4*)(so + 512) = (f32x4){Sb.p[0].x, Sb.p[0].y, Sb.p[1].x, Sb.p[1].y}; *(f32x4*)(so + 516) = (f32x4){Sb.p[2].x, Sb.p[2].y, Sb.p[3].x, Sb.p[3].y};
    }
    if (MODE == 1) {
        float* po = u.Pout + (size_t)vr0 * 64 + 8 * ks;
        *(f32x4*)po = (f32x4){Pa.p[0].x, Pa.p[0].y, Pa.p[1].x, Pa.p[1].y}; *(f32x4*)(po + 4) = (f32x4){Pa.p[2].x, Pa.p[2].y, Pa.p[3].x, Pa.p[3].y};
        *(f32x4*)(po + 512) = (f32x4){Pb.p[0].x, Pb.p[0].y, Pb.p[1].x, Pb.p[1].y}; *(f32x4*)(po + 516) = (f32x4){Pb.p[2].x, Pb.p[2].y, Pb.p[3].x, Pb.p[3].y};
    }
}
__device__ __forceinline__ void scan_combine(LAS unsigned char* lds, CArgsP a) {
    if (blockIdx.x >= 64) return;
    const int tid = threadIdx.x, h = blockIdx.x >> 3, rw = tid >> 6, v = (blockIdx.x & 7) * 8 + rw, kq = tid & 63;
    const float* PM = (const float*)(a->ws + WS_PM); const float* UM = (const float*)(a->ws + WS_UM); float* SS = (float*)(a->ws + WS_SS);
    LAS float* Sl = (LAS float*)lds;
    LAS float* Pl = (LAS float*)(lds + 4096);
    constexpr int GL = NSEG - 2;
    float cur = SS[((size_t)(1 * 8 + h) * 64 + v) * 64 + kq];
    f32x4 pa, pb;
    float u1, u2;
    {
        const f32x4* P1 = (const f32x4*)(PM + (size_t)(1 * 8 + h) * 4096);
        *(LAS f32x4*)(Pl + 1 * 4096 + 4 * tid) = P1[tid]; *(LAS f32x4*)(Pl + 1 * 4096 + 2048 + 4 * tid) = P1[512 + tid];
        if (GL >= 2) { const f32x4* P2 = (const f32x4*)(PM + (size_t)(2 * 8 + h) * 4096);
            *(LAS f32x4*)(Pl + 2 * 4096 + 4 * tid) = P2[tid]; *(LAS f32x4*)(Pl + 2 * 4096 + 2048 + 4 * tid) = P2[512 + tid]; }
        u1 = UM[((size_t)(1 * 8 + h) * 64 + v) * 64 + kq];
        u2 = GL >= 2 ? UM[((size_t)(2 * 8 + h) * 64 + v) * 64 + kq] : 0.f;
    }
    for (int g = 1; g <= GL; ++g) {
        const bool pf = (g + 2 <= GL);
        float u3 = 0.f;
        if (pf) { const f32x4* Pn = (const f32x4*)(PM + (size_t)((g + 2) * 8 + h) * 4096); pa = Pn[tid]; pb = Pn[512 + tid]; u3 = UM[((size_t)((g + 2) * 8 + h) * 64 + v) * 64 + kq]; }
        asm volatile("s_waitcnt lgkmcnt(0)\n\ts_barrier" ::: "memory");
        const LAS float* Pg = Pl + (g % 3) * 4096 + kq;
        float acc0 = u1, acc1 = 0.f, acc2 = 0.f, acc3 = 0.f;
        const int curi = __builtin_bit_cast(int, cur);
#pragma unroll
        for (int k = 0; k < 64; k += 4) {
            const float s0 = __builtin_bit_cast(float, __builtin_amdgcn_readlane(curi, k)), s1 = __builtin_bit_cast(float, __builtin_amdgcn_readlane(curi, k + 1));
            const float s2 = __builtin_bit_cast(float, __builtin_amdgcn_readlane(curi, k + 2)), s3 = __builtin_bit_cast(float, __builtin_amdgcn_readlane(curi, k + 3));
            acc0 += s0 * Pg[(k + 0) * 64]; acc1 += s1 * Pg[(k + 1) * 64]; acc2 += s2 * Pg[(k + 2) * 64]; acc3 += s3 * Pg[(k + 3) * 64];
        }
        cur = (acc0 + acc1) + (acc2 + acc3);
        SS[((size_t)((g + 1) * 8 + h) * 64 + v) * 64 + kq] = cur;
        if (pf) { LAS float* dst = Pl + ((g + 2) % 3) * 4096; *(LAS f32x4*)(dst + 4 * tid) = pa; *(LAS f32x4*)(dst + 2048 + 4 * tid) = pb; }
        u1 = u2; u2 = u3;
    }
}

constexpr size_t WS_BAR = 512 * 1024, BAR_BYTES = 16 * 1024;
constexpr int LDS_MISC = 131072 + 64;
#define XB_TMO      128
#define XB_XCNT(j)  (256  + 64 * (j))
#define XB_XSUB(j)  (1280 + 64 * (j))
#define XB_XGEN(j)  (2304 + 64 * (j))
#define XB_TOP      3328
#define XB_TOPGEN   3392
#define XCD_BAR_WORDS 3456
#define XB_SPIN_CAP (1u << 18)

__device__ __forceinline__ unsigned xb_ld(unsigned* p)              { return __hip_atomic_load(p, __ATOMIC_RELAXED, __HIP_MEMORY_SCOPE_AGENT); }
__device__ __forceinline__ unsigned xb_add(unsigned* p, unsigned v) { return __hip_atomic_fetch_add(p, v, __ATOMIC_RELAXED, __HIP_MEMORY_SCOPE_AGENT); }
__device__ __forceinline__ unsigned xb_xcc_id() { return (unsigned)__builtin_amdgcn_s_getreg((3 << 11) | 20) & 0xFu; }
#define XB_SPIN(cond, bar) do { unsigned _sp = 0; while (cond) { __builtin_amdgcn_s_sleep(1); \
    if ((++_sp & 255u) == 0u) { if (xb_ld(&(bar)[XB_TMO])) break; if (_sp > XB_SPIN_CAP) { atomicAdd(&(bar)[XB_TMO], 1u); break; } } } } while (0)

struct XcdBarrier {
    unsigned* bar; unsigned x;
    volatile LAS unsigned* st;
};

__device__ __forceinline__ XcdBarrier xcd_barrier_post(unsigned* bar, volatile LAS unsigned* st) {
    XcdBarrier b; b.bar = bar; b.x = xb_xcc_id(); b.st = st;
    if (threadIdx.x == 0) (void)xb_add(&bar[XB_XCNT(b.x)], 1u);
    return b;
}
__device__ __forceinline__ void xcd_barrier_complete(unsigned* bar, unsigned x, unsigned& nloc, unsigned& nx) {
    const unsigned G = gridDim.x * gridDim.y * gridDim.z;
    unsigned sum, cnt, mine, sp = 0u;
    for (;;) {
        sum = 0u; cnt = 0u; mine = 0u;
#pragma unroll
        for (unsigned j = 0; j < 16; ++j) { const unsigned c = xb_ld(&bar[XB_XCNT(j)]); sum += c; cnt += (c > 0u) ? 1u : 0u; mine = (j == x) ? c : mine; }
        if (sum == G) break;
        __builtin_amdgcn_s_sleep(1);
        if ((++sp & 255u) == 0u) { if (xb_ld(&bar[XB_TMO])) break; if (sp > XB_SPIN_CAP) { atomicAdd(&bar[XB_TMO], 1u); break; } }
    }
    nloc = mine > 0u ? mine : 1u; nx = cnt > 0u ? cnt : 1u;
}

__device__ __forceinline__ void xcd_barrier(const XcdBarrier& b) {
    asm volatile("s_waitcnt vmcnt(0)" ::: "memory");
    __syncthreads();
    if (threadIdx.x == 0) {
        unsigned* bar = b.bar;
        __builtin_amdgcn_s_waitcnt(0);
        unsigned nloc = b.st[0], nx = b.st[1];
        if (nloc == 0u) { xcd_barrier_complete(bar, b.x, nloc, nx); b.st[0] = nloc; b.st[1] = nx; }
        const unsigned old = xb_add(&bar[XB_XSUB(b.x)], 1u);
        const unsigned gen = old / nloc;
        if (old + 1u == (gen + 1u) * nloc) {
            __builtin_amdgcn_fence(__ATOMIC_RELEASE, "agent");
            asm volatile("s_waitcnt vmcnt(0)" ::: "memory");
            const unsigned og = xb_add(&bar[XB_TOP], 1u);
            const unsigned tg = og / nx;
            if (og + 1u == (tg + 1u) * nx) xb_add(&bar[XB_TOPGEN], 1u);
            else XB_SPIN(xb_ld(&bar[XB_TOPGEN]) == tg, bar);
            __builtin_amdgcn_fence(__ATOMIC_ACQUIRE, "agent");
            xb_add(&bar[XB_XGEN(b.x)], 1u);
            asm volatile("s_waitcnt vmcnt(0)" ::: "memory");
        } else {
            XB_SPIN(xb_ld(&bar[XB_XGEN(b.x)]) == gen, bar);
            __builtin_amdgcn_fence(__ATOMIC_ACQUIRE, "agent");
            asm volatile("s_waitcnt vmcnt(0)" ::: "memory");
        }
    }
    __syncthreads();
}

__device__ __forceinline__ void grid_bar(LAS unsigned char* lds) {
    CArgsP a = get_args(); XcdBarrier b; b.bar = (unsigned*)(a->ws + WS_BAR); b.x = xb_xcc_id(); b.st = (volatile LAS unsigned*)(lds + LDS_MISC);
    xcd_barrier(b);
}

constexpr int CNT_FFN1 = 3840, CNT_FFN2 = 3904;
struct SampleFirstOrder {
    int nM, nN, nwg, G, c, nS; unsigned* cnt;
    __device__ void init(int M, int N, int G_, int c_, unsigned* cnt_) { nM = M / 256; nN = N / 256; nwg = nM * nN; G = G_; c = c_; nS = nN; cnt = cnt_; }
    __device__ bool next(int i, pg8::Unit& u) const {
        long L = (long)i * G + c;
        if (G == 256 && nN == 22) {
            if (c >= G - 4) { if (i >= 3) return false; }
            else if (c >= G - 12 && i == 5) { const int k = c - (G - 12); L = (long)(3 + (k >> 2)) * G + (G - 4 + (k & 3)); }
        }
        if (L < nS) { u.pm = nM; u.pn = (int)L; return true; }
        L -= nS; if (L >= nwg) return false;
        int wgid = (int)L; { const int q = nwg / pg8::NXCD, r = nwg % pg8::NXCD, xcd = wgid % pg8::NXCD, off = wgid / pg8::NXCD; wgid = (xcd < r ? xcd * (q + 1) : r * (q + 1) + (xcd - r) * q) + off; }
        const int nig = pg8::WGM * nN, gid = wgid / nig, fm = gid * pg8::WGM, gsz = (nM - fm) < pg8::WGM ? (nM - fm) : pg8::WGM;
        u.pm = fm + ((wgid % nig) % gsz); u.pn = (wgid % nig) / gsz; return true;
    }
    __device__ __forceinline__ void a_ready(const pg8::Unit&) const {}
    __device__ __forceinline__ void done(const pg8::Unit& u) const {
        if (u.pm == nM) { __builtin_amdgcn_fence(__ATOMIC_RELEASE, "agent"); if ((threadIdx.x & 63) == 0) __hip_atomic_fetch_add(cnt, 1u, __ATOMIC_RELAXED, __HIP_MEMORY_SCOPE_AGENT); }
    }
};
struct OneUnit {
    int pm, pn;
    __device__ bool next(int i, pg8::Unit& u) const { if (i) return false; u.pm = pm; u.pn = pn; return true; }
    __device__ __forceinline__ void a_ready(const pg8::Unit&) const {}
    __device__ __forceinline__ void done(const pg8::Unit&) const {}
};
__device__ __forceinline__ void wait_count(unsigned* cnt, unsigned want) {
    if (threadIdx.x == 0) {
        unsigned sp = 0;
        while (__hip_atomic_load(cnt, __ATOMIC_RELAXED, __HIP_MEMORY_SCOPE_AGENT) < want && ++sp < (1u << 24)) __builtin_amdgcn_s_sleep(2);
        __builtin_amdgcn_fence(__ATOMIC_ACQUIRE, "agent");
        asm volatile("s_waitcnt vmcnt(0)" ::: "memory");
    }
    __syncthreads();
}

#ifdef PROBE_PHASE
__device__ __forceinline__ int probe_reps(int k) { int n = (k == PROBE_PHASE) ? 2 : 1; asm volatile("" : "+s"(n)); return n; }
#define PH(k) for (int r_ = 0, n_ = probe_reps(k); r_ < n_; ++r_)
#else
#define PH(k)
#endif
constexpr int LDS_BYTES = 136 * 1024;
__global__ void __launch_bounds__(512, 2) mega_fwd(Args a_unused) {
    extern __shared__ __attribute__((aligned(16))) unsigned char lds_raw[];
    cg::grid_group grid = cg::this_grid();
    LAS unsigned char* lds = (LAS unsigned char*)lds_raw;
    const int tid = threadIdx.x, lane = tid & 63, wave = __builtin_amdgcn_readfirstlane(tid >> 6);
    const int G = gridDim.x, bx = blockIdx.x;
    if (tid < 64) ((LAS unsigned*)(lds + 131072))[tid] = 0u;
    __syncthreads();

    { CArgsP a = get_args(); phase0(a, lds, wave, lane);
      if (bx == 0) { unsigned* bw = (unsigned*)(a->ws + WS_BAR); for (int i = tid; i < (int)(BAR_BYTES / 4); i += 512) bw[i] = 0u; } }
    grid.sync();
    { CArgsP a = get_args(); (void)xcd_barrier_post((unsigned*)(a->ws + WS_BAR), (volatile LAS unsigned*)(lds + LDS_MISC)); }
    PH(1) { CArgsP a = get_args(); unsigned char* ws = a->ws; unsigned* cnt = (unsigned*)(ws + WS_BAR) + CNT_FFN1;
      { pg8::Gemm g{(const bf16_t*)(ws + WS_XB), (const bf16_t*)(ws + WS_W1I), MROWS, 2 * DFF, DM}; SampleFirstOrder S; S.init(TP, 2 * DFF, G, bx, cnt);
        EpiSwiglu E{(bf16_t*)(ws + WS_H), (const float*)(ws + WS_ROWSQ0)}; pg8::gemm_phase<EpiSwiglu, SampleFirstOrder, true, true>(lds, g, S, E); }
      if (bx >= G - 4) {
        wait_count(cnt, 8u * (2 * DFF / 256));
        pg8::Gemm g{(const bf16_t*)(ws + WS_H), (const bf16_t*)(ws + WS_W1O), MROWS, DM, DFF}; OneUnit S{TP / 256, bx - (G - 4)};
        EpiResid E{a->in[0], a->in[1], a->out, (bf16_t*)(ws + WS_XB), (float*)(ws + WS_ROWSQ1), 0.5f, 0}; pg8::gemm_phase<EpiResid, OneUnit, true, true>(lds, g, S, E); } }
    grid_bar(lds);
    PH(2) { CArgsP a = get_args(); unsigned char* ws = a->ws;
      pg8::Gemm g{(const bf16_t*)(ws + WS_H), (const bf16_t*)(ws + WS_W1O), TP, DM, DFF}; pg8::StaticOrder S; S.init(TP, DM, G, bx);
      EpiResid E{a->in[0], a->in[1], a->out, (bf16_t*)(ws + WS_XB), (float*)(ws + WS_ROWSQ1), 0.5f, 0}; pg8::gemm_phase<EpiResid, pg8::StaticOrder, true, true>(lds, g, S, E); }
    grid_bar(lds);
    PH(3) { CArgsP a = get_args(); unsigned char* ws = a->ws;
      pg8::Gemm g{(const bf16_t*)(ws + WS_XB), (const bf16_t*)(ws + WS_WIN), MROWS, NPROJ, DM}; pg8::StaticOrder S; S.init(MROWS, NPROJ, G, bx);
      EpiProj E{(const float*)(ws + WS_ROWSQ1), ws, a->out, a->in[14], a->in[15], a->in[13]};
      pg8::gemm_phase<EpiProj, pg8::StaticOrder, true, true>(lds, g, S, E); }
    grid_bar(lds);
    PH(4) { CArgsP a = get_args(); phase4(a, wave, lane); }
    grid_bar(lds);
    { CArgsP a = get_args(); cum_fixup(a); }
    PH(5) { CArgsP a = get_args(); unsigned char* ws = a->ws;

      int kl = KLORA; asm volatile("" : "+s"(kl));
      pg8::Gemm g{(const bf16_t*)(ws + WS_LORAA), (const bf16_t*)(ws + WS_WLORA), MROWS, NLORA, kl}; pg8::StaticOrder S; S.init(MROWS, NLORA, G, bx);
      EpiBf16N E{(bf16_t*)(ws + WS_LORA), NLORA}; pg8::gemm_phase<EpiBf16N, pg8::StaticOrder, true, true>(lds, g, S, E);
      if (G == 256 && bx >= 134) convert_weights(a, lds, wave, lane, 1, bx - 134, 122); }
    grid_bar(lds);
    PH(6) {
        CArgsP a = get_args();
        float gqm = 0.f, gkm = 0.f;
        { const float gq = fabsf(a->in[14][lane]), gk = fabsf(a->in[15][lane]); gqm = wave_max(gq); gkm = wave_max(gk); }
        const float thr = 30.f + 16.f * gqm * gkm;
        float* SS = (float*)(a->ws + WS_SS); float* PM = (float*)(a->ws + WS_PM); float* UM = (float*)(a->ws + WS_UM);
        const int half = tid >> 8;
        constexpr int NUPP = 4 * (NSEG - 2), NSC = 4 + NUPP;
        PH(10) for (int it = bx; it < NSC; it += G) {
            if (it < 4) { const int hh = 2 * it + half; ScanUnit u{0, hh, 0, nullptr, SS + (size_t)(1 * 8 + hh) * 4096, nullptr}; scan_pair<0>(lds, a, u, SEGCH); }
            else { const int uu = 2 * (it - 4) + half, g = 1 + (uu >> 3), hh = uu & 7;
                ScanUnit u{0, hh, g * SEGCH, nullptr, UM + (size_t)(g * 8 + hh) * 4096, PM + (size_t)(g * 8 + hh) * 4096}; scan_pair<1>(lds, a, u, SEGCH); }
        }
        if (G == 256) {
            int a0, an;
            if (bx >= 252) { a0 = 500 + 3 * (bx - 252); an = 3; } else if (bx >= 4) { a0 = 2 * (bx - 4); an = 2; } else { a0 = 496 + bx; an = 1; }
            PH(11) for (int it = a0; it < a0 + an; ++it) attn_unit(lds, a, it & 7, 63 - (it >> 3), thr);
        } else {
            for (int it = (bx + G - NSC % G) % G; it < 512; it += G) attn_unit(lds, a, it & 7, 63 - (it >> 3), thr);
        }
        if (G != 256) for (int it = G - 1 - bx; it < 128; it += G) attn_sample_unit(lds, a, it >> 3, it & 7);
        if (G != 256) for (int it = ((G - 129 - bx) % G + G) % G; it < 64; it += G) {
            const int uu = 2 * it + half, sb = uu >> 3, hh = uu & 7;
            ScanUnit u{1 + sb, hh, 0, a->in[5] + (size_t)(sb * 8 + hh) * 4096, a->out + OFF_STS + (size_t)(sb * 8 + hh) * 4096, nullptr}; scan_pair<0>(lds, a, u, 1);
        }
    }
    grid_bar(lds);
    PH(7) { CArgsP a = get_args(); if (bx < 64 || G <= 64) scan_combine(lds, a); __syncthreads(); if (G != 256 && (bx >= 64 || G <= 64)) convert_weights(a, lds, wave, lane, 1, G <= 64 ? bx : bx - 64, G <= 64 ? G : G - 64); if (G == 256 && bx >= 64 && bx < 192) attn_sample_unit(lds, a, (bx - 64) >> 3, (bx - 64) & 7);
      if (G == 256 && bx >= 192) {
          const int uu = 2 * (bx - 192) + (tid >> 8), sb = uu >> 3, hh = uu & 7;
          ScanUnit u{1 + sb, hh, 0, a->in[5] + (size_t)(sb * 8 + hh) * 4096, a->out + OFF_STS + (size_t)(sb * 8 + hh) * 4096, nullptr}; scan_pair<0>(lds, a, u, 1);
      } }
    grid_bar(lds);
    PH(8) { CArgsP a = get_args();
      float* SS = (float*)(a->ws + WS_SS);
      const int half = tid >> 8;
      PH(14) for (int it = bx; it < 4 * (NSEG - 1); it += G) {
          const int uu = 2 * it + half, g = 1 + (uu >> 3), hh = uu & 7;
          ScanUnit u{0, hh, g * SEGCH, SS + (size_t)(g * 8 + hh) * 4096, g == NSEG - 1 ? a->out + OFF_STP + (size_t)hh * 4096 : nullptr, nullptr};
          scan_pair<0>(lds, a, u, SEGCH);
      }
      if (bx >= G - 4) {
        unsigned char* ws = a->ws;
        pg8::Gemm g{(const bf16_t*)(ws + WS_XB), (const bf16_t*)(ws + WS_WOUT), MROWS, DM, DM}; OneUnit S{TP / 256, bx - (G - 4)};
        EpiResid E{nullptr, nullptr, a->out, (bf16_t*)(ws + WS_X2B), (float*)(ws + WS_ROWSQ2), 1.0f, 1}; pg8::gemm_phase<EpiResid, OneUnit, true, true>(lds, g, S, E); }
    }
    grid_bar(lds);
    { CArgsP a = get_args(); unsigned char* ws = a->ws;
      pg8::Gemm g{(const bf16_t*)(ws + WS_XB), (const bf16_t*)(ws + WS_WOUT), TP, DM, DM}; pg8::StaticOrder S; S.init(TP, DM, G, bx);
      EpiResid E{nullptr, nullptr, a->out, (bf16_t*)(ws + WS_X2B), (float*)(ws + WS_ROWSQ2), 1.0f, 1}; pg8::gemm_phase<EpiResid, pg8::StaticOrder, true, true>(lds, g, S, E); }
    grid_bar(lds);
    PH(9) { CArgsP a = get_args(); unsigned char* ws = a->ws; unsigned* cnt = (unsigned*)(ws + WS_BAR) + CNT_FFN2;
      { pg8::Gemm g{(const bf16_t*)(ws + WS_X2B), (const bf16_t*)(ws + WS_W2I), MROWS, 2 * DFF, DM}; SampleFirstOrder S; S.init(TP, 2 * DFF, G, bx, cnt);
        EpiSwiglu E{(bf16_t*)(ws + WS_H), (const float*)(ws + WS_ROWSQ2)}; pg8::gemm_phase<EpiSwiglu, SampleFirstOrder, true, true>(lds, g, S, E); }
      if (bx >= G - 4) {
        wait_count(cnt, 8u * (2 * DFF / 256));
        pg8::Gemm g{(const bf16_t*)(ws + WS_H), (const bf16_t*)(ws + WS_W2O), MROWS, DM, DFF}; OneUnit S{TP / 256, bx - (G - 4)};
        EpiResid E{nullptr, nullptr, a->out, nullptr, nullptr, 0.5f, 1}; pg8::gemm_phase<EpiResid, OneUnit, true, true>(lds, g, S, E); } }
    grid_bar(lds);
    { CArgsP a = get_args(); unsigned char* ws = a->ws;
      pg8::Gemm g{(const bf16_t*)(ws + WS_H), (const bf16_t*)(ws + WS_W2O), TP, DM, DFF}; pg8::StaticOrder S; S.init(TP, DM, G, bx);
      EpiResid E{nullptr, nullptr, a->out, nullptr, nullptr, 0.5f, 1}; pg8::gemm_phase<EpiResid, pg8::StaticOrder, true, true>(lds, g, S, E); }
}

extern "C" void kernel_launch(void* const* d_in, const int* in_sizes, int n_in, void* d_out, int out_size, void* d_ws, size_t ws_size, hipStream_t stream) {
    static int grid = 0;
    if (grid == 0) {
        if (n_in != 30 || out_size != (int)OUT_TOTAL || ws_size < WS_END || in_sizes[0] != TP * DM) { fprintf(stderr, "kernel_launch: unexpected shapes (n_in %d out %d ws %zu)\n", n_in, out_size, ws_size); grid = -1; return; }
        int dev = 0, cus = 0, per_cu = 0;
        if (hipGetDevice(&dev) != hipSuccess || hipDeviceGetAttribute(&cus, hipDeviceAttributeMultiprocessorCount, dev) != hipSuccess) { grid = -1; return; }
        if (hipFuncSetAttribute((const void*)mega_fwd, hipFuncAttributeMaxDynamicSharedMemorySize, LDS_BYTES) != hipSuccess) { fprintf(stderr, "kernel_launch: hipFuncSetAttribute failed\n"); grid = -1; return; }
        if (hipOccupancyMaxActiveBlocksPerMultiprocessor(&per_cu, (const void*)mega_fwd, 512, LDS_BYTES) != hipSuccess || per_cu < 1) { fprintf(stderr, "kernel_launch: occupancy query failed (%d)\n", per_cu); (void)hipGetLastError(); grid = -1; return; }
        grid = cus * per_cu;
    }
    if (grid < 64) return;
    Args a{};
    for (int i = 0; i < 30; ++i) a.in[i] = (const float*)d_in[i];
    a.out = (float*)d_out; a.ws = (unsigned char*)d_ws;
    void* args[] = {&a};
    hipError_t e = hipLaunchCooperativeKernel((const void*)mega_fwd, dim3(grid), dim3(512), args, LDS_BYTES, stream);
    if (e != hipSuccess) fprintf(stderr, "kernel_launch: cooperative launch failed: %s (grid %d)\n", hipGetErrorString(e), grid);
}
```
